# Optimizing an MI355X kernel written in HIP

```python
import jax, jax.numpy as jnp
from jax import lax
import numpy as np

D_MODEL = 1024
BATCH = 8
SEQ = 2048
DEPTH = 1
DEC_BATCH = 8
DEC_SEQ = 16
PAST_LEN = 1024

CHUNK = 64
Q_BLOCK = 128
D_MIX = D_MODEL
SB_WIDTH = D_MIX // 2
SB_HEAD_DIM = 64
SB_HEADS = SB_WIDTH // SB_HEAD_DIM
HG_WIDTH = D_MIX - SB_WIDTH
HG_HEAD_DIM = 128
HG_HEADS = HG_WIDTH // HG_HEAD_DIM
SPLIT_WIDTHS = [SB_WIDTH] * 4 + [HG_WIDTH] * 4
D_IN = sum(SPLIT_WIDTHS)
DEEPNORM_ALPHA = (2 * DEPTH) ** 0.25
DEEPNORM_BETA = (8 * DEPTH) ** -0.25
LN_EPS = 1e-5
RMS_EPS = 1e-6

kernel_name = "stickbreak_hgrn2_deepnorm_stream_step"


def layer_norm(x, g, b):
    x = x.astype(jnp.float32)
    mu = jnp.mean(x, axis=-1, keepdims=True)
    var = jnp.mean(jnp.square(x - mu), axis=-1, keepdims=True)
    return (x - mu) * lax.rsqrt(var + LN_EPS) * g.astype(jnp.float32) + b.astype(jnp.float32)


def stick_breaking_attention(q, k, v, q_offset):
    B, H, Tq, dh = q.shape
    Tk = k.shape[2]
    blk = min(Q_BLOCK, Tq)
    nb = Tq // blk
    scale = dh ** -0.5
    kf = k.astype(jnp.float32)
    vf = v.astype(jnp.float32)
    kpos = jnp.arange(Tk)
    qb = q.astype(jnp.float32).reshape(B, H, nb, blk, dh).transpose(2, 0, 1, 3, 4)
    starts = q_offset + blk * jnp.arange(nb)

    def one_block(args):
        qblk, start = args
        qpos = start + jnp.arange(blk)
        z = jnp.einsum('bhqd,bhkd->bhqk', qblk, kf) * scale
        mask = kpos[None, :] < qpos[:, None]
        log_keep = jnp.where(mask, jax.nn.log_sigmoid(-z), 0.0)
        later = lax.cumsum(log_keep, axis=3, reverse=True) - log_keep
        w = jnp.where(mask, jnp.exp(jax.nn.log_sigmoid(z) + later), 0.0)
        return jnp.einsum('bhqk,bhkd->bhqd', w, vf)

    o = lax.map(one_block, (qb, starts))
    return o.transpose(1, 2, 0, 3, 4).reshape(B, H, Tq, dh)


def hgrn2_recurrence(q, k, g, i, s0):
    B, H, T, dk = q.shape
    dv = i.shape[-1]
    c = min(CHUNK, T)
    n = T // c

    def to_chunks(a):
        return a.reshape(B, H, n, c, a.shape[-1]).transpose(2, 0, 1, 3, 4)

    causal = jnp.tril(jnp.ones((c, c), dtype=bool))[:, :, None]

    def step(S, xs):
        qc, kc, gc, ic = xs
        b = jnp.cumsum(gc, axis=2)
        diff = b[:, :, :, None, :] - b[:, :, None, :, :]
        decay = jnp.where(causal, jnp.exp(jnp.minimum(diff, 0.0)), 0.0)
        scores = jnp.einsum('bhtd,bhsd,bhtsd->bhts', qc, kc, decay)
        o = (jnp.einsum('bhts,bhsv->bhtv', scores, ic)
             + jnp.einsum('bhtd,bhdv->bhtv', qc * jnp.exp(b), S))
        b_last = b[:, :, -1:, :]
        S_new = (jnp.exp(b_last)[:, :, 0, :, None] * S
                 + jnp.einsum('bhsd,bhsv->bhdv', kc * jnp.exp(b_last - b), ic))
        return S_new, o

    S_fin, o = lax.scan(step, s0, (to_chunks(q), to_chunks(k), to_chunks(g), to_chunks(i)))
    return o.transpose(1, 2, 0, 3, 4).reshape(B, H, T, dv), S_fin


def encoder_layer(x, past_k, past_v, s0, w_in, w_out, lb, norm_g, ln_g, ln_b, q_offset):
    Bn, T, _ = x.shape
    proj = jnp.einsum('btd,de->bte', x, w_in)
    idx = [int(v) for v in np.cumsum(SPLIT_WIDTHS)[:-1]]
    qa, ka, va, ga, qh, fh, ih, gh = jnp.split(proj, idx, axis=-1)

    def heads(a, h):
        return a.reshape(Bn, T, h, -1).transpose(0, 2, 1, 3)

    qa, ka, va = heads(qa, SB_HEADS), heads(ka, SB_HEADS), heads(va, SB_HEADS)
    if past_k is None:
        k_all, v_all = ka, va
    else:
        k_all = jnp.concatenate([past_k.astype(ka.dtype), ka], axis=2)
        v_all = jnp.concatenate([past_v.astype(va.dtype), va], axis=2)
    o_sb = stick_breaking_attention(qa, k_all, v_all, q_offset)
    o_sb = o_sb.transpose(0, 2, 1, 3).reshape(Bn, T, SB_WIDTH) * jax.nn.silu(ga.astype(jnp.float32))

    f = lb + (1.0 - lb) * jax.nn.sigmoid(fh.astype(jnp.float32))
    g_log = jnp.log(f)
    k_in = 1.0 - f
    q_h = jax.nn.silu(qh.astype(jnp.float32))
    o_hg, s_new = hgrn2_recurrence(heads(q_h, HG_HEADS), heads(k_in, HG_HEADS),
                                   heads(g_log, HG_HEADS), heads(ih.astype(jnp.float32), HG_HEADS),
                                   s0.astype(jnp.float32))
    o_hg = o_hg * lax.rsqrt(jnp.mean(jnp.square(o_hg), axis=-1, keepdims=True) + RMS_EPS)
    o_hg = (o_hg.transpose(0, 2, 1, 3).reshape(Bn, T, HG_WIDTH) * norm_g.astype(jnp.float32)
            * jax.nn.silu(gh.astype(jnp.float32)))

    mixed = jnp.concatenate([o_sb, o_hg], axis=-1).astype(x.dtype)
    out = jnp.einsum('bte,ed->btd', mixed, w_out)
    y = layer_norm(DEEPNORM_ALPHA * x.astype(jnp.float32) + out.astype(jnp.float32), ln_g, ln_b)
    return y.astype(x.dtype), ka, va, s_new


def setup_inputs(seed: int = 0) -> dict:
    key = jax.random.key(seed)
    ks = jax.random.split(key, 12)
    f32 = jnp.float32
    x_prompt = jax.random.normal(ks[0], (BATCH, SEQ, D_MODEL), f32)
    x_sample = jax.random.normal(ks[1], (DEC_BATCH, DEC_SEQ, D_MODEL), f32)
    cache_k = jax.random.normal(ks[2], (DEPTH, DEC_BATCH, SB_HEADS, PAST_LEN, SB_HEAD_DIM), f32)
    cache_v = DEEPNORM_BETA * jax.random.normal(ks[3], (DEPTH, DEC_BATCH, SB_HEADS, PAST_LEN, SB_HEAD_DIM), f32)
    state_s = 0.5 * jax.random.normal(ks[4], (DEPTH, DEC_BATCH, HG_HEADS, HG_HEAD_DIM, HG_HEAD_DIM), f32)
    col_scale = jnp.concatenate([
        jnp.ones((SB_WIDTH * 2,), f32), jnp.full((SB_WIDTH,), DEEPNORM_BETA, f32), jnp.ones((SB_WIDTH,), f32),
        jnp.ones((HG_WIDTH * 2,), f32), jnp.full((HG_WIDTH,), DEEPNORM_BETA, f32), jnp.ones((HG_WIDTH,), f32)])
    w_in = jax.random.normal(ks[5], (DEPTH, D_MODEL, D_IN), f32) * (D_MODEL ** -0.5) * col_scale
    w_out = jax.random.normal(ks[6], (DEPTH, D_MIX, D_MODEL), f32) * (D_MIX ** -0.5) * DEEPNORM_BETA
    lb_logits = 0.1 * jax.random.normal(ks[7], (DEPTH + 1, HG_WIDTH), f32)
    hgrn_norm_g = 1.0 + 0.01 * jax.random.normal(ks[8], (DEPTH, HG_WIDTH), f32)
    ln_g = 1.0 + 0.01 * jax.random.normal(ks[9], (DEPTH, D_MODEL), f32)
    ln_b = 0.01 * jax.random.normal(ks[10], (DEPTH, D_MODEL), f32)
    return {"x_prompt": x_prompt, "x_sample": x_sample, "cache_k": cache_k, "cache_v": cache_v,
            "state_s": state_s, "w_in": w_in, "w_out": w_out, "lb_logits": lb_logits,
            "hgrn_norm_g": hgrn_norm_g, "ln_g": ln_g, "ln_b": ln_b}


def reference(x_prompt, x_sample, cache_k, cache_v, state_s, w_in, w_out, lb_logits,
              hgrn_norm_g, ln_g, ln_b):
    lower_bounds = jnp.cumsum(jax.nn.softmax(lb_logits.astype(jnp.float32), axis=0), axis=0)
    past_len = cache_k.shape[3]
    yp, ys = x_prompt, x_sample
    kp_l, vp_l, sp_l, ks_l, vs_l, ss_l = [], [], [], [], [], []
    for l in range(DEPTH):
        s0p = jnp.zeros((x_prompt.shape[0], HG_HEADS, HG_HEAD_DIM, HG_HEAD_DIM), jnp.float32)
        yp, kp, vp, sp = encoder_layer(yp, None, None, s0p, w_in[l], w_out[l], lower_bounds[l],
                                       hgrn_norm_g[l], ln_g[l], ln_b[l], 0)
        ys, kn, vn, sn = encoder_layer(ys, cache_k[l], cache_v[l], state_s[l], w_in[l], w_out[l],
                                       lower_bounds[l], hgrn_norm_g[l], ln_g[l], ln_b[l], past_len)
        kp_l.append(kp); vp_l.append(vp); sp_l.append(sp)
        ks_l.append(kn); vs_l.append(vn); ss_l.append(sn)
    return (yp, ys, jnp.stack(kp_l), jnp.stack(vp_l), jnp.stack(sp_l),
            jnp.stack(ks_l), jnp.stack(vs_l), jnp.stack(ss_l))
```

```cpp
#include <hip/hip_runtime.h>
#include <hip/hip_cooperative_groups.h>
#include <cstdio>
namespace cg = cooperative_groups;

#define DI __device__ __forceinline__
#define LAS __attribute__((address_space(3)))
typedef unsigned short u16;
typedef short bf16x8 __attribute__((ext_vector_type(8)));
typedef short s16x4 __attribute__((ext_vector_type(4)));
typedef float f32x4 __attribute__((ext_vector_type(4)));
typedef float f32x2 __attribute__((ext_vector_type(2)));
typedef float f32x16 __attribute__((ext_vector_type(16)));
typedef unsigned u32x4 __attribute__((ext_vector_type(4)));
typedef unsigned u32x2 __attribute__((ext_vector_type(2)));
typedef __bf16 bf16x2_t __attribute__((ext_vector_type(2)));

constexpr int NP = 16384;
constexpr int NTOK = 16512;
constexpr int MPAD = 16640;
constexpr float ALPHA = 1.189207115002721f;
constexpr float QSCALE = 0.18033688011112042f;
constexpr float RSTOP = 150.0f;

constexpr size_t O_YP = 0, O_YS = 16777216, O_KP = 16908288, O_VP = 25296896, O_SP = 33685504, O_KS = 34209792, O_VS = 34275328, O_SS = 34340864;

constexpr size_t SZ_XB = (size_t)MPAD * 1024 * 2;
constexpr size_t SZ_H = (size_t)MPAD * 512 * 2;
constexpr size_t OFF_XB = 0;
constexpr size_t OFF_WINT = OFF_XB + SZ_XB;
constexpr size_t OFF_WOUTT = OFF_WINT + (size_t)4096 * 1024 * 2;
constexpr size_t OFF_QA = OFF_WOUTT + (size_t)1024 * 1024 * 2;
constexpr size_t OFF_KA = OFF_QA + SZ_H;
constexpr size_t OFF_VA = OFF_KA + SZ_H;
constexpr size_t OFF_GA = OFF_VA + SZ_H;
constexpr size_t OFF_QH = OFF_GA + SZ_H;
constexpr size_t OFF_IH = OFF_QH + SZ_H;
constexpr size_t OFF_GH = OFF_IH + SZ_H;
constexpr size_t OFF_G = OFF_GH + SZ_H;
constexpr size_t OFF_SLOC = OFF_G + (size_t)MPAD * 512 * 4;
constexpr size_t OFF_BLAST = OFF_SLOC + (size_t)1024 * 16384 * 2;
constexpr size_t OFF_STATS = OFF_BLAST + (size_t)1024 * 128 * 4;
constexpr size_t OFF_CTR = OFF_STATS + (size_t)65 * 4 * 256 * 2 * 4;
constexpr size_t SZ_CTR = 65 * 64 * 4;
constexpr size_t WS_END = OFF_CTR + SZ_CTR;
constexpr int LDS_BYTES = 131072;
#ifndef PHMASK
#define PHMASK 63
#endif

struct P {
    const float *x_prompt, *x_sample, *cache_k, *cache_v, *state_s, *w_in, *w_out, *lb_logits, *norm_g, *ln_g, *ln_b;
    float* out;
    unsigned char* ws;
    int ph_lo, ph_hi;
};

DI unsigned pk_bf16(float lo, float hi) { f32x2 v = {lo, hi}; bf16x2_t b = __builtin_convertvector(v, bf16x2_t); return __builtin_bit_cast(unsigned, b); }
DI u16 bf1(float x) { return (u16)(pk_bf16(x, 0.f) & 0xffffu); }
DI float bf2f(u16 v) { return __uint_as_float(((unsigned)v) << 16); }
DI float bflo(unsigned v) { return __uint_as_float(v << 16); }
DI float bfhi(unsigned v) { return __uint_as_float(v & 0xffff0000u); }
DI float ex2(float x) { return __builtin_amdgcn_exp2f(x); }
DI float lg2(float x) { return __builtin_amdgcn_logf(x); }
DI float sigm(float x) { return 1.f / (1.f + __expf(-x)); }
DI float silu(float x) { return x / (1.f + __expf(-x)); }
DI int crow(int i, int h) { return (i & 3) + 8 * (i >> 2) + 4 * h; }
DI bf16x8 pack8(const float* w) { u32x4 r; r[0] = pk_bf16(w[0], w[1]); r[1] = pk_bf16(w[2], w[3]); r[2] = pk_bf16(w[4], w[5]); r[3] = pk_bf16(w[6], w[7]); return __builtin_bit_cast(bf16x8, r); }
DI bf16x8 pack8v(float4 a, float4 b) { u32x4 r; r[0] = pk_bf16(a.x, a.y); r[1] = pk_bf16(a.z, a.w); r[2] = pk_bf16(b.x, b.y); r[3] = pk_bf16(b.z, b.w); return __builtin_bit_cast(bf16x8, r); }
DI bf16x8 tr2(LAS unsigned char* lo, LAS unsigned char* hi) {
    s16x4 a = __builtin_amdgcn_ds_read_tr16_b64_v4i16((LAS s16x4*)lo);
    s16x4 b = __builtin_amdgcn_ds_read_tr16_b64_v4i16((LAS s16x4*)hi);
    return __builtin_shufflevector(a, b, 0, 1, 2, 3, 4, 5, 6, 7);
}
#define MFMA32(a, b, c) __builtin_amdgcn_mfma_f32_32x32x16_bf16((a), (b), (c), 0, 0, 0)

namespace pg8 {
constexpr int BM = 256, BK = 64, HALF = 128, HTB = HALF * BK * 2, STAGE_BYTES = 8 * HTB, NXCD = 8, WGM = 8;
DI int lds_byte(int r, int c) { const int st = (r >> 4) * 2 + (c >> 5), rr = r & 15, cc = c & 31, ob = rr * 64 + cc * 2; return st * 1024 + (ob ^ (((ob >> 9) & 1) << 5)); }
DI void stage_rc(int b, int& R, int& C) { const int st = b / 1024, sb = b % 1024, swz = sb ^ (((sb >> 9) & 1) << 5); R = (st >> 1) * 16 + swz / 64; C = (st & 1) * 32 + (swz % 64) / 2; }
struct Unit { int pm, pn; };
struct Gemm { const u16* A; const u16* Bt; int M, N, K; };
struct StaticOrder {
    int nM, nN, nwg, G, c;
    DI void init(int M, int N, int G_, int c_) { nM = M / BM; nN = N / BM; nwg = nM * nN; G = G_; c = c_; }
    DI bool next(int i, Unit& u) const {
        const long L = (long)i * G + c; if (L >= nwg) return false;
        int wgid = (int)L; { const int q = nwg / NXCD, r = nwg % NXCD, xcd = wgid % NXCD, off = wgid / NXCD; wgid = (xcd < r ? xcd * (q + 1) : r * (q + 1) + (xcd - r) * q) + off; }
        const int nig = WGM * nN, gid = wgid / nig, fm = gid * WGM, gsz = (nM - fm) < WGM ? (nM - fm) : WGM;
        u.pm = fm + ((wgid % nig) % gsz); u.pn = (wgid % nig) / gsz; return true;
    }
};
struct SingleUnit {
    int pm, pn;
    DI bool next(int i, Unit& u) const { if (i) return false; u.pm = pm; u.pn = pn; return true; }
};

template <class Epi, class Sched>
DI void gemm_phase(LAS unsigned char* lds, const Gemm g, const Sched& S, const Epi& E) {
    const int tid = threadIdx.x, wid = __builtin_amdgcn_readfirstlane(tid >> 6), lane = tid & 63, wr = wid >> 2, wc = wid & 3, fr = lane & 15, fq = lane >> 4;
    const int K = g.K, nt = K / BK;
    unsigned voffA[2], voffB[2];
#pragma unroll
    for (int i = 0; i < 2; ++i) { int R, C; stage_rc(tid * 16 + i * 8192, R, C); voffA[i] = (unsigned)(R * K + C) * 2u; voffB[i] = voffA[i]; }
    const size_t kstep = (size_t)(BK * 2);
    const size_t hstep = (size_t)HALF * K * 2;
    const size_t tstep = 2 * hstep;
    const unsigned ldsw = (unsigned)wid * 1024u;
    const int aoff = lds_byte(wr * 64 + fr, fq * 8), boff = lds_byte(wc * 32 + fr, fq * 8);
#define PG8_SA(b, h) (((b) * 2 + (h)) * HTB)
#define PG8_SB(b, h) ((4 + (b) * 2 + (h)) * HTB)
#define PG8_STAGE(bufoff, gbase, voff) do { _Pragma("unroll") for (int _i = 0; _i < 2; ++_i) \
        __builtin_amdgcn_global_load_lds((const unsigned*)((const char*)(gbase) + (voff)[_i]), (LAS unsigned*)(lds + (bufoff) + ldsw + _i * 8192), 16, 0, 0); } while (0)
#define PG8_LDA(dst, b, h) do { _Pragma("unroll") for (int m = 0; m < 4; ++m) _Pragma("unroll") for (int k = 0; k < 2; ++k) dst[m][k] = *(const LAS bf16x8*)(lds + PG8_SA(b, h) + aoff + m * 2048 + k * 1024); } while (0)
#define PG8_LDB(dst, b, h) do { _Pragma("unroll") for (int n = 0; n < 2; ++n) _Pragma("unroll") for (int k = 0; k < 2; ++k) dst[n][k] = *(const LAS bf16x8*)(lds + PG8_SB(b, h) + boff + n * 2048 + k * 1024); } while (0)
#define PG8_MMA(ai, bj, At, Bt) do { __builtin_amdgcn_s_setprio(1); _Pragma("unroll") for (int m = 0; m < 4; ++m) _Pragma("unroll") for (int n = 0; n < 2; ++n) _Pragma("unroll") for (int k = 0; k < 2; ++k) \
        acc[ai][bj][m][n] = __builtin_amdgcn_mfma_f32_16x16x32_bf16(Bt[n][k], At[m][k], acc[ai][bj][m][n], 0, 0, 0); __builtin_amdgcn_s_setprio(0); } while (0)
#define PG8_WAIT_V(n) asm volatile("s_waitcnt vmcnt(" #n ")" ::: "memory")
#define PG8_WAIT_L(n) asm volatile("s_waitcnt lgkmcnt(" #n ")" ::: "memory")
#define PG8_BAR __builtin_amdgcn_s_barrier()
#define PG8_SCHED __builtin_amdgcn_sched_barrier(0)
    Unit cur, nxt; int ui = 0;
    if (!S.next(0, cur)) return;
    f32x4 acc[2][2][4][2];
#pragma unroll
    for (int a = 0; a < 2; ++a)
#pragma unroll
        for (int b = 0; b < 2; ++b)
#pragma unroll
            for (int m = 0; m < 4; ++m)
#pragma unroll
                for (int n = 0; n < 2; ++n) acc[a][b][m][n] = (f32x4){0.f, 0.f, 0.f, 0.f};
    bf16x8 At[4][2], B0[2][2], B1[2][2];
    const char* cA = (const char*)g.A + (size_t)cur.pm * tstep; const char* cB = (const char*)g.Bt + (size_t)cur.pn * tstep;
    PG8_STAGE(PG8_SB(0, 0), cB, voffB); PG8_STAGE(PG8_SA(0, 0), cA, voffA); PG8_STAGE(PG8_SB(0, 1), cB + hstep, voffB); PG8_STAGE(PG8_SA(0, 1), cA + hstep, voffA);
    if (wr == 1) PG8_BAR;
    PG8_WAIT_V(4); PG8_BAR;
    PG8_STAGE(PG8_SB(1, 0), cB + kstep, voffB); PG8_STAGE(PG8_SA(1, 0), cA + kstep, voffA); PG8_STAGE(PG8_SB(1, 1), cB + hstep + kstep, voffB);
    PG8_WAIT_V(6); PG8_BAR;
    for (;;) {
        const bool has_next = S.next(ui + 1, nxt);
        const char* nA = has_next ? (const char*)g.A + (size_t)nxt.pm * tstep : cA; const char* nB = has_next ? (const char*)g.Bt + (size_t)nxt.pn * tstep : cB;
        for (int t = 0; t < nt; t += 2) {
            const bool last = (t == nt - 2);
            const char* a1 = cA + (size_t)(t + 1) * kstep;
            const char* a2 = last ? nA : cA + (size_t)(t + 2) * kstep; const char* b2 = last ? nB : cB + (size_t)(t + 2) * kstep;
            const char* a3 = a2 + kstep; const char* b3 = b2 + kstep;
            PG8_LDB(B0, 0, 0); PG8_SCHED; PG8_LDA(At, 0, 0); PG8_STAGE(PG8_SA(1, 1), a1 + hstep, voffA);
            PG8_WAIT_L(8); PG8_BAR; PG8_WAIT_L(0); PG8_MMA(0, 0, At, B0); PG8_BAR; PG8_SCHED;
            PG8_LDB(B1, 0, 1); PG8_STAGE(PG8_SB(0, 0), b2, voffB);
            PG8_BAR; PG8_WAIT_L(0); PG8_MMA(0, 1, At, B1); PG8_BAR;
            PG8_LDA(At, 0, 1); PG8_STAGE(PG8_SA(0, 0), a2, voffA);
            PG8_BAR; PG8_WAIT_L(0); PG8_MMA(1, 0, At, B0); PG8_BAR; PG8_SCHED;
            PG8_STAGE(PG8_SB(0, 1), b2 + hstep, voffB);
            PG8_WAIT_V(6); PG8_BAR; PG8_MMA(1, 1, At, B1); PG8_BAR;
            PG8_LDB(B0, 1, 0); PG8_SCHED; PG8_LDA(At, 1, 0); PG8_STAGE(PG8_SA(0, 1), a2 + hstep, voffA);
            PG8_WAIT_L(8); PG8_BAR; PG8_WAIT_L(0); PG8_MMA(0, 0, At, B0); PG8_BAR; PG8_SCHED;
            PG8_LDB(B1, 1, 1); PG8_STAGE(PG8_SB(1, 0), b3, voffB);
            PG8_BAR; PG8_WAIT_L(0); PG8_MMA(0, 1, At, B1); PG8_BAR;
            PG8_LDA(At, 1, 1); PG8_STAGE(PG8_SA(1, 0), a3, voffA);
            PG8_BAR; PG8_WAIT_L(0); PG8_MMA(1, 0, At, B0); PG8_BAR; PG8_SCHED;
            PG8_STAGE(PG8_SB(1, 1), b3 + hstep, voffB);
            PG8_WAIT_V(6); PG8_BAR; PG8_MMA(1, 1, At, B1); PG8_BAR;
        }
        if constexpr (!Epi::AFTER_DRAIN) { int fr2 = fr, fq2 = fq, wr2 = wr, wc2 = wc; asm volatile("" : "+v"(fr2), "+v"(fq2), "+s"(wr2), "+s"(wc2)); E(acc, cur, wr2, wc2, fr2, fq2); }
        if (!has_next) break;
#pragma unroll
        for (int a = 0; a < 2; ++a)
#pragma unroll
            for (int b = 0; b < 2; ++b)
#pragma unroll
                for (int m = 0; m < 4; ++m)
#pragma unroll
                    for (int n = 0; n < 2; ++n) acc[a][b][m][n] = (f32x4){0.f, 0.f, 0.f, 0.f};
        cur = nxt; cA = nA; cB = nB; ++ui;
    }
    PG8_WAIT_V(0);
    if (wr == 0) PG8_BAR;
    PG8_BAR;
    if constexpr (Epi::AFTER_DRAIN) { int fr2 = fr, fq2 = fq, wr2 = wr, wc2 = wc, tid2 = tid; asm volatile("" : "+v"(fr2), "+v"(fq2), "+s"(wr2), "+s"(wc2), "+v"(tid2)); E.fused(acc, cur, wr2, wc2, fr2, fq2, lds, tid2); }
#undef PG8_SA
#undef PG8_SB
#undef PG8_STAGE
#undef PG8_LDA
#undef PG8_LDB
#undef PG8_MMA
#undef PG8_WAIT_V
#undef PG8_WAIT_L
#undef PG8_BAR
#undef PG8_SCHED
}
}

struct EpiProj {
    static constexpr bool PERM = false, AFTER_DRAIN = false;
    P p;
    template <int SEG>
    DI void seg(const f32x4 (&acc)[2][2][4][2], const pg8::Unit& u, int wr, int wc, int fr, int fq) const {
        unsigned char* ws = p.ws;
        const int colt = (u.pn & 1) * 256 + wc * 32 + 4 * fq;
        f32x4 aux[2][2];
        if constexpr (SEG == 5) {
#pragma unroll
            for (int bj = 0; bj < 2; ++bj)
#pragma unroll
                for (int n = 0; n < 2; ++n) { const int cc = colt + bj * 128 + n * 16; const f32x4 l0 = *(const f32x4*)(p.lb_logits + cc), l1 = *(const f32x4*)(p.lb_logits + 512 + cc);
#pragma unroll
                    for (int j = 0; j < 4; ++j) aux[bj][n][j] = 1.f / (1.f + __expf(l1[j] - l0[j])); }
        }
        if constexpr (SEG == 7) {
#pragma unroll
            for (int bj = 0; bj < 2; ++bj)
#pragma unroll
                for (int n = 0; n < 2; ++n) aux[bj][n] = *(const f32x4*)(p.norm_g + colt + bj * 128 + n * 16);
        }
#pragma unroll
        for (int ai = 0; ai < 2; ++ai)
#pragma unroll
            for (int m = 0; m < 4; ++m) {
                const int row = u.pm * 256 + ai * 128 + wr * 64 + m * 16 + fr;
                if (row >= NTOK) continue;
#pragma unroll
                for (int bj = 0; bj < 2; ++bj)
#pragma unroll
                    for (int n = 0; n < 2; ++n) {
                        const int cc = colt + bj * 128 + n * 16;
                        f32x4 v = acc[ai][bj][m][n];
                        if constexpr (SEG == 5) {
                            f32x4 g;
#pragma unroll
                            for (int j = 0; j < 4; ++j) { const float lb = aux[bj][n][j]; g[j] = __logf(lb + (1.f - lb) * sigm(v[j])); }
                            *(f32x4*)((float*)(ws + OFF_G) + (size_t)row * 512 + cc) = g;
                        } else {
                            if constexpr (SEG == 1 || SEG == 2) {
                                const int hd = cc >> 6, d = cc & 63;
                                float* o;
                                if (row < NP) { const int b = row >> 11, t = row & 2047; o = p.out + (SEG == 1 ? O_KP : O_VP) + ((size_t)((b * 8 + hd) * 2048 + t)) * 64 + d; }
                                else { const int rs = row - NP, b = rs >> 4, t = rs & 15; o = p.out + (SEG == 1 ? O_KS : O_VS) + ((size_t)((b * 8 + hd) * 16 + t)) * 64 + d; }
                                *(f32x4*)o = v;
                            }
                            if constexpr (SEG == 0) { v = v * QSCALE; }
                            if constexpr (SEG == 3 || SEG == 4) {
#pragma unroll
                                for (int j = 0; j < 4; ++j) v[j] = silu(v[j]);
                            }
                            if constexpr (SEG == 7) {
#pragma unroll
                                for (int j = 0; j < 4; ++j) v[j] = silu(v[j]) * aux[bj][n][j];
                            }
                            constexpr size_t off = SEG == 0 ? OFF_QA : SEG == 1 ? OFF_KA : SEG == 2 ? OFF_VA : SEG == 3 ? OFF_GA : SEG == 4 ? OFF_QH : SEG == 6 ? OFF_IH : OFF_GH;
                            u32x2 w; w[0] = pk_bf16(v[0], v[1]); w[1] = pk_bf16(v[2], v[3]);
                            *(u32x2*)((u16*)(ws + off) + (size_t)row * 512 + cc) = w;
                        }
                    }
            }
    }
    DI void operator()(const f32x4 (&acc)[2][2][4][2], const pg8::Unit& u, int wr, int wc, int fr, int fq) const {
        switch (u.pn >> 1) {
            case 0: seg<0>(acc, u, wr, wc, fr, fq); break;
            case 1: seg<1>(acc, u, wr, wc, fr, fq); break;
            case 2: seg<2>(acc, u, wr, wc, fr, fq); break;
            case 3: seg<3>(acc, u, wr, wc, fr, fq); break;
            case 4: seg<4>(acc, u, wr, wc, fr, fq); break;
            case 5: seg<5>(acc, u, wr, wc, fr, fq); break;
            case 6: seg<6>(acc, u, wr, wc, fr, fq); break;
            default: seg<7>(acc, u, wr, wc, fr, fq); break;
        }
    }
};

struct EpiLN {
    static constexpr bool PERM = false, AFTER_DRAIN = true;
    P p;
    DI void fused(f32x4 (&acc)[2][2][4][2], const pg8::Unit& u, int wr, int wc, int fr, int fq, LAS unsigned char* lds, int tid) const {
        LAS float* red = (LAS float*)lds;
        LAS float* rowstat = (LAS float*)(lds + 8192);
        float* stats = (float*)(p.ws + OFF_STATS);
        unsigned* ctr = (unsigned*)(p.ws + OFF_CTR) + u.pm * 64;
        const int col0 = u.pn * 256 + wc * 32 + 4 * fq;
#pragma unroll
        for (int ai = 0; ai < 2; ++ai)
#pragma unroll
            for (int m = 0; m < 4; ++m) {
                const int rl = ai * 128 + wr * 64 + m * 16 + fr, row = u.pm * 256 + rl;
                const float* xr = row < NP ? p.x_prompt + (size_t)row * 1024 : p.x_sample + (size_t)((row < NTOK ? row : NP) - NP) * 1024;
                float a1 = 0.f, a2 = 0.f;
#pragma unroll
                for (int bj = 0; bj < 2; ++bj)
#pragma unroll
                    for (int n = 0; n < 2; ++n) {
                        const f32x4 xv = *(const f32x4*)(xr + col0 + bj * 128 + n * 16);
                        const f32x4 v = xv * ALPHA + acc[ai][bj][m][n];
                        acc[ai][bj][m][n] = v;
                        a1 += (v[0] + v[1]) + (v[2] + v[3]);
                        a2 += (v[0] * v[0] + v[1] * v[1]) + (v[2] * v[2] + v[3] * v[3]);
                    }
                a1 += __shfl_xor(a1, 16); a2 += __shfl_xor(a2, 16);
                a1 += __shfl_xor(a1, 32); a2 += __shfl_xor(a2, 32);
                if (fq == 0) { red[(rl * 4 + wc) * 2] = a1; red[(rl * 4 + wc) * 2 + 1] = a2; }
                asm volatile("" ::: "memory");
            }
        __syncthreads();
        if (tid < 256) {
            float s1 = 0.f, s2 = 0.f;
#pragma unroll
            for (int w = 0; w < 4; ++w) { s1 += red[(tid * 4 + w) * 2]; s2 += red[(tid * 4 + w) * 2 + 1]; }
            float* dst = stats + ((size_t)(u.pm * 4 + u.pn) * 256 + tid) * 2;
            __hip_atomic_store(dst, s1, __ATOMIC_RELAXED, __HIP_MEMORY_SCOPE_AGENT);
            __hip_atomic_store(dst + 1, s2, __ATOMIC_RELAXED, __HIP_MEMORY_SCOPE_AGENT);
        }
        __threadfence();
        __syncthreads();
        if (tid == 0) {
            __hip_atomic_fetch_add(ctr, 1u, __ATOMIC_RELEASE, __HIP_MEMORY_SCOPE_AGENT);
            while (__hip_atomic_load(ctr, __ATOMIC_ACQUIRE, __HIP_MEMORY_SCOPE_AGENT) < 4u) __builtin_amdgcn_s_sleep(2);
        }
        __syncthreads();
        __threadfence();
        if (tid < 256) {
            float s1 = 0.f, s2 = 0.f;
#pragma unroll
            for (int o = 0; o < 4; ++o) {
                const float* src = stats + ((size_t)(u.pm * 4 + o) * 256 + tid) * 2;
                s1 += __hip_atomic_load(src, __ATOMIC_RELAXED, __HIP_MEMORY_SCOPE_AGENT);
                s2 += __hip_atomic_load(src + 1, __ATOMIC_RELAXED, __HIP_MEMORY_SCOPE_AGENT);
            }
            const float mean = s1 * (1.f / 1024.f);
            const float var = fmaxf(s2 * (1.f / 1024.f) - mean * mean, 0.f);
            rowstat[tid * 2] = mean; rowstat[tid * 2 + 1] = rsqrtf(var + 1e-5f);
        }
        __syncthreads();
        f32x4 gv[2][2], bv[2][2];
#pragma unroll
        for (int bj = 0; bj < 2; ++bj)
#pragma unroll
            for (int n = 0; n < 2; ++n) { gv[bj][n] = *(const f32x4*)(p.ln_g + col0 + bj * 128 + n * 16); bv[bj][n] = *(const f32x4*)(p.ln_b + col0 + bj * 128 + n * 16); }
#pragma unroll
        for (int ai = 0; ai < 2; ++ai)
#pragma unroll
            for (int m = 0; m < 4; ++m) {
                const int rl = ai * 128 + wr * 64 + m * 16 + fr, row = u.pm * 256 + rl;
                if (row >= NTOK) continue;
                const float mean = rowstat[rl * 2], rstd = rowstat[rl * 2 + 1];
                float* yr = row < NP ? p.out + O_YP + (size_t)row * 1024 : p.out + O_YS + (size_t)(row - NP) * 1024;
#pragma unroll
                for (int bj = 0; bj < 2; ++bj)
#pragma unroll
                    for (int n = 0; n < 2; ++n) *(f32x4*)(yr + col0 + bj * 128 + n * 16) = (acc[ai][bj][m][n] - mean) * rstd * gv[bj][n] + bv[bj][n];
                asm volatile("" ::: "memory");
            }
    }
};

DI void phase0(const P& p, unsigned char* shm) {
    const int tid = threadIdx.x, nb = gridDim.x, bid = blockIdx.x;
    u16* XB = (u16*)(p.ws + OFF_XB);
    const size_t n8p = (size_t)NP * 128, n8 = (size_t)NTOK * 128;
    for (size_t i = (size_t)bid * 512 + tid; i < n8; i += (size_t)nb * 512) {
        const float4* src = (i < n8p) ? ((const float4*)p.x_prompt + 2 * i) : ((const float4*)p.x_sample + 2 * (i - n8p));
        const float4 a = src[0], b = src[1];
        uint4 o; o.x = pk_bf16(a.x, a.y); o.y = pk_bf16(a.z, a.w); o.z = pk_bf16(b.x, b.y); o.w = pk_bf16(b.z, b.w);
        ((uint4*)XB)[i] = o;
    }
    for (int i = bid * 512 + tid; i < 16384; i += nb * 512) ((uint4*)(XB + (size_t)NTOK * 1024))[i] = make_uint4(0u, 0u, 0u, 0u);
    u16* tile = (u16*)shm;
    for (int t = bid; t < 1280; t += nb) {
        const float* W; u16* WT; int N, kt, ntl;
        if (t < 1024) { W = p.w_in; WT = (u16*)(p.ws + OFF_WINT); N = 4096; kt = t >> 6; ntl = t & 63; }
        else { const int u = t - 1024; W = p.w_out; WT = (u16*)(p.ws + OFF_WOUTT); N = 1024; kt = u >> 4; ntl = u & 15; }
        {
            const int k = tid >> 3, n0 = (tid & 7) * 8;
            const float4* s = (const float4*)(W + (size_t)(kt * 64 + k) * N + ntl * 64 + n0);
            const float4 a = s[0], b = s[1];
            tile[(n0 + 0) * 66 + k] = bf1(a.x); tile[(n0 + 1) * 66 + k] = bf1(a.y); tile[(n0 + 2) * 66 + k] = bf1(a.z); tile[(n0 + 3) * 66 + k] = bf1(a.w);
            tile[(n0 + 4) * 66 + k] = bf1(b.x); tile[(n0 + 5) * 66 + k] = bf1(b.y); tile[(n0 + 6) * 66 + k] = bf1(b.z); tile[(n0 + 7) * 66 + k] = bf1(b.w);
        }
        __syncthreads();
        {
            const int n = tid >> 3, k0 = (tid & 7) * 8;
            const unsigned* r = (const unsigned*)(tile + n * 66 + k0);
            uint4 o; o.x = r[0]; o.y = r[1]; o.z = r[2]; o.w = r[3];
            *(uint4*)(WT + (size_t)(ntl * 64 + n) * 1024 + kt * 64 + k0) = o;
        }
        __syncthreads();
    }
}

template <bool SAMPLE>
DI void attn_wave(const P& p, int item, LAS unsigned char* vl, int lane) {
    const int col = lane & 31, h = lane >> 5;
    const int gi = (lane >> 4) & 1, i16 = lane & 15, tq = i16 >> 2, tp = i16 & 3;
    const u16* QA = (const u16*)(p.ws + OFF_QA);
    int b, hd, qt; size_t qrow;
    if (SAMPLE) { b = item >> 3; hd = item & 7; qt = 32; qrow = (size_t)NP + b * 16 + (col < 15 ? col : 15); }
    else { const int bh = item >> 6; qt = item & 63; b = bh >> 3; hd = bh & 7; qrow = (size_t)b * 2048 + 32 * qt + col; }
    const int qcol = SAMPLE ? (col < 15 ? col : 15) : col;
    bf16x8 qf[4];
#pragma unroll
    for (int s = 0; s < 4; ++s) qf[s] = *(const bf16x8*)(QA + qrow * 512 + hd * 64 + 16 * s + 8 * h);
    f32x16 o0, o1;
#pragma unroll
    for (int i = 0; i < 16; ++i) { o0[i] = 0.f; o1[i] = 0.f; }
    float R = 0.f;
    const u16* kbase = (const u16*)(p.ws + OFF_KA) + (size_t)b * 2048 * 512 + hd * 64;
    const u16* vbase = (const u16*)(p.ws + OFF_VA) + (size_t)b * 2048 * 512 + hd * 64;
    const float* ck = p.cache_k + (size_t)(b * 8 + hd) * 1024 * 64;
    const float* cv = p.cache_v + (size_t)(b * 8 + hd) * 1024 * 64;
    const float* nk = p.out + O_KS + (size_t)(b * 8 + hd) * 16 * 64;
    const float* nv = p.out + O_VS + (size_t)(b * 8 + hd) * 16 * 64;
    for (int j = qt; j >= 0; --j) {
        bf16x8 kf[4]; u32x4 vr[4];
        if (!SAMPLE) {
            const u16* kp = kbase + (size_t)(32 * j + col) * 512 + 8 * h;
#pragma unroll
            for (int s = 0; s < 4; ++s) kf[s] = *(const bf16x8*)(kp + 16 * s);
#pragma unroll
            for (int i = 0; i < 4; ++i) { const int c = lane + 64 * i; vr[i] = *(const u32x4*)(vbase + (size_t)(32 * j + (c >> 3)) * 512 + (c & 7) * 8); }
        } else {
            const bool fresh = (j == 32);
            const float* ksrc = fresh ? nk : ck; const float* vsrc = fresh ? nv : cv;
            const int r = fresh ? (col < 15 ? col : 15) : 32 * j + col;
            const float* kp = ksrc + (size_t)r * 64 + 8 * h;
#pragma unroll
            for (int s = 0; s < 4; ++s) kf[s] = pack8v(*(const float4*)(kp + 16 * s), *(const float4*)(kp + 16 * s + 4));
#pragma unroll
            for (int i = 0; i < 4; ++i) { const int c = lane + 64 * i; const int row = c >> 3; const int rr = fresh ? (row < 15 ? row : 15) : 32 * j + row;
                const float* vp = vsrc + (size_t)rr * 64 + (c & 7) * 8; const bf16x8 t8 = pack8v(*(const float4*)vp, *(const float4*)(vp + 4)); vr[i] = __builtin_bit_cast(u32x4, t8); }
        }
#pragma unroll
        for (int i = 0; i < 4; ++i) { const int c = lane + 64 * i; *(LAS u32x4*)(vl + (c >> 3) * 144 + (c & 7) * 16) = vr[i]; }
        f32x16 st;
#pragma unroll
        for (int i = 0; i < 16; ++i) st[i] = 0.f;
#pragma unroll
        for (int s = 0; s < 4; ++s) st = MFMA32(kf[s], qf[s], st);
        const bool diag = (j == qt);
        float z[16], sp[16], w[16];
#pragma unroll
        for (int i = 0; i < 16; ++i) {
            const float zz = fminf(st[i], 126.f);
            float s_ = lg2(1.f + ex2(zz));
            if (diag && !(crow(i, h) < qcol)) s_ = 0.f;
            z[i] = zz; sp[i] = s_;
        }
        float Go[4], Gp[4];
#pragma unroll
        for (int m = 0; m < 4; ++m) { Go[m] = (sp[4 * m] + sp[4 * m + 1]) + (sp[4 * m + 2] + sp[4 * m + 3]); Gp[m] = __shfl_xor(Go[m], 32); }
        float base = R;
#pragma unroll
        for (int m = 3; m >= 0; --m) {
            const float bm = base + (h == 0 ? Gp[m] : 0.f);
            const float c3 = bm + sp[4 * m + 3], c2 = c3 + sp[4 * m + 2], c1 = c2 + sp[4 * m + 1], c0 = c1 + sp[4 * m];
            w[4 * m + 3] = ex2(z[4 * m + 3] - c3); w[4 * m + 2] = ex2(z[4 * m + 2] - c2); w[4 * m + 1] = ex2(z[4 * m + 1] - c1); w[4 * m] = ex2(z[4 * m] - c0);
            base += Go[m] + Gp[m];
        }
        R = base;
        if (diag) {
#pragma unroll
            for (int i = 0; i < 16; ++i) if (!(crow(i, h) < qcol)) w[i] = 0.f;
        }
        const bf16x8 pw0 = pack8(w), pw1 = pack8(w + 8);
#pragma unroll
        for (int s2 = 0; s2 < 2; ++s2) {
            LAS unsigned char* lo = vl + (16 * s2 + 4 * h + tq) * 144 + (16 * gi + 4 * tp) * 2;
            const bf16x8 a0 = tr2(lo, lo + 8 * 144);
            const bf16x8 a1 = tr2(lo + 64, lo + 8 * 144 + 64);
            o0 = MFMA32(a0, s2 ? pw1 : pw0, o0);
            o1 = MFMA32(a1, s2 ? pw1 : pw0, o1);
        }
        if (__all(R >= RSTOP)) break;
    }
    if (!SAMPLE || col < 16) {
        const size_t row = SAMPLE ? (size_t)NP + b * 16 + col : (size_t)b * 2048 + 32 * qt + col;
        const u16* GA = (const u16*)(p.ws + OFF_GA) + row * 512 + hd * 64;
        u16* MX = (u16*)(p.ws + OFF_XB) + row * 1024 + hd * 64;
#pragma unroll
        for (int dh = 0; dh < 2; ++dh)
#pragma unroll
            for (int g4 = 0; g4 < 4; ++g4) {
                const int d0 = 32 * dh + 8 * g4 + 4 * h;
                const u32x2 ga = *(const u32x2*)(GA + d0);
                const float v0 = (dh ? o1[4 * g4] : o0[4 * g4]) * bflo(ga[0]), v1 = (dh ? o1[4 * g4 + 1] : o0[4 * g4 + 1]) * bfhi(ga[0]);
                const float v2 = (dh ? o1[4 * g4 + 2] : o0[4 * g4 + 2]) * bflo(ga[1]), v3 = (dh ? o1[4 * g4 + 3] : o0[4 * g4 + 3]) * bfhi(ga[1]);
                u32x2 wv; wv[0] = pk_bf16(v0, v1); wv[1] = pk_bf16(v2, v3);
                *(u32x2*)(MX + d0) = wv;
            }
    }
}

DI void chunk_cumsum(const float* gp  , float (&gv)[16], float (&bc)[16], LAS float* segsum, int d, int seg, float& off, float& tot) {
#pragma unroll
    for (int i = 0; i < 16; ++i) gv[i] = gp[(size_t)i * 512];
    float run = 0.f;
#pragma unroll
    for (int i = 0; i < 16; ++i) { run += gv[i]; bc[i] = run; }
    segsum[seg * 128 + d] = run;
    __syncthreads();
    off = 0.f; tot = 0.f;
#pragma unroll
    for (int s4 = 0; s4 < 4; ++s4) { const float x = segsum[s4 * 128 + d]; tot += x; off += (s4 < seg) ? x : 0.f; }
}

DI void hgrn_local(const P& p, int ch, LAS unsigned char* L) {
    const int tid = threadIdx.x, wid = tid >> 6, lane = tid & 63;
    const int bh = ch >> 5, c = ch & 31, b = bh >> 2, hh = bh & 3;
    const size_t row0 = (size_t)b * 2048 + 64 * c;
    LAS float* segsum = (LAS float*)L;
    LAS unsigned char* KT = L + 2048;
    LAS unsigned char* II = L + 2048 + 18432;
    LAS unsigned char* OUTS = L + 2048 + 18432 + 17408;
    const int d = tid & 127, seg = tid >> 7;
    float gv[16], bc[16], off, tot;
    {
        const u16* IH = (const u16*)(p.ws + OFF_IH) + row0 * 512 + hh * 128;
#pragma unroll
        for (int i = 0; i < 2; ++i) { const int cc = tid + 512 * i; const int r = cc >> 4, c16 = cc & 15; *(LAS u32x4*)(II + r * 272 + c16 * 16) = *(const u32x4*)(IH + (size_t)r * 512 + c16 * 8); }
    }
    chunk_cumsum((const float*)(p.ws + OFF_G) + (row0 + 16 * seg) * 512 + hh * 128 + d, gv, bc, segsum, d, seg, off, tot);
    {
        float kx[16];
#pragma unroll
        for (int i = 0; i < 16; ++i) kx[i] = (1.f - __expf(gv[i])) * __expf(tot - (off + bc[i]));
        *(LAS bf16x8*)(KT + d * 144 + seg * 32) = pack8(kx);
        *(LAS bf16x8*)(KT + d * 144 + seg * 32 + 16) = pack8(kx + 8);
        if (seg == 0) ((float*)(p.ws + OFF_BLAST))[(size_t)ch * 128 + d] = tot;
    }
    __syncthreads();
    {
        const int col = lane & 31, h = lane >> 5, gi = (lane >> 4) & 1, i16 = lane & 15, tq = i16 >> 2, tp = i16 & 3;
        const int vt = wid >> 1, dt0 = 2 * (wid & 1);
        f32x16 a0, a1;
#pragma unroll
        for (int i = 0; i < 16; ++i) { a0[i] = 0.f; a1[i] = 0.f; }
#pragma unroll
        for (int ks = 0; ks < 4; ++ks) {
            LAS unsigned char* lo = II + (16 * ks + 8 * h + tq) * 272 + (32 * vt + 16 * gi + 4 * tp) * 2;
            const bf16x8 A = tr2(lo, lo + 4 * 272);
            const bf16x8 B0 = *(const LAS bf16x8*)(KT + (32 * dt0 + col) * 144 + (16 * ks + 8 * h) * 2);
            const bf16x8 B1 = *(const LAS bf16x8*)(KT + (32 * (dt0 + 1) + col) * 144 + (16 * ks + 8 * h) * 2);
            a0 = MFMA32(A, B0, a0); a1 = MFMA32(A, B1, a1);
        }
#pragma unroll
        for (int i = 0; i < 16; ++i) {
            const int v = 32 * vt + crow(i, h);
            *(LAS u16*)(OUTS + v * 272 + (32 * dt0 + col) * 2) = bf1(a0[i]);
            *(LAS u16*)(OUTS + v * 272 + (32 * (dt0 + 1) + col) * 2) = bf1(a1[i]);
        }
    }
    __syncthreads();
    {
        u16* SL = (u16*)(p.ws + OFF_SLOC) + (size_t)ch * 16384;
#pragma unroll
        for (int i = 0; i < 4; ++i) { const int cc = tid + 512 * i; const int r = cc >> 4, c16 = cc & 15; *(u32x4*)(SL + r * 128 + c16 * 8) = *(const LAS u32x4*)(OUTS + r * 272 + c16 * 16); }
    }
}

DI void hgrn_scan(const P& p, int first_block) {
    const int nthreads = ((int)gridDim.x - first_block) * 512, t0 = ((int)blockIdx.x - first_block) * 512 + (int)threadIdx.x;
    for (int gidx = t0; gidx < 65536; gidx += nthreads) {
        const int dg = gidx & 15, v = (gidx >> 4) & 127, bh = gidx >> 11;
        float S[8];
#pragma unroll
        for (int j = 0; j < 8; ++j) S[j] = 0.f;
        u16* base = (u16*)(p.ws + OFF_SLOC) + ((size_t)bh * 32 * 128 + v) * 128 + dg * 8;
        const float* bl = (const float*)(p.ws + OFF_BLAST) + (size_t)bh * 32 * 128 + dg * 8;
#pragma unroll 8
        for (int c = 0; c < 32; ++c) {
            const u32x4 raw = *(const u32x4*)(base + (size_t)c * 16384);
            const f32x4 d0 = *(const f32x4*)(bl + c * 128), d1 = *(const f32x4*)(bl + c * 128 + 4);
            u32x4 o; o[0] = pk_bf16(S[0], S[1]); o[1] = pk_bf16(S[2], S[3]); o[2] = pk_bf16(S[4], S[5]); o[3] = pk_bf16(S[6], S[7]);
            *(u32x4*)(base + (size_t)c * 16384) = o;
#pragma unroll
            for (int j = 0; j < 4; ++j) {
                S[2 * j] = S[2 * j] * __expf(j < 2 ? d0[2 * j] : d1[2 * j - 4]) + bflo(raw[j]);
                S[2 * j + 1] = S[2 * j + 1] * __expf(j < 2 ? d0[2 * j + 1] : d1[2 * j - 3]) + bfhi(raw[j]);
            }
        }
        float* os = p.out + O_SP + ((size_t)bh * 128 + dg * 8) * 128 + v;
#pragma unroll
        for (int j = 0; j < 8; ++j) os[(size_t)j * 128] = S[j];
    }
}

DI void hgrn_out(const P& p, int ch, LAS unsigned char* L) {
    const int tid = threadIdx.x, wid = tid >> 6, lane = tid & 63;
    const int bh = ch >> 5, c = ch & 31, b = bh >> 2, hh = bh & 3;
    const size_t row0 = (size_t)b * 2048 + 64 * c;
    LAS float* segsum = (LAS float*)L;
    LAS unsigned char* QE = L + 2048;
    LAS unsigned char* KE = L + 2048 + 17408;
    LAS unsigned char* II = L + 2048 + 2 * 17408;
    LAS float* ssq = (LAS float*)(L + 2048 + 3 * 17408);
    const int d = tid & 127, seg = tid >> 7;
    float gv[16], bc[16], off, tot;
    {
        const u16* IH = (const u16*)(p.ws + OFF_IH) + row0 * 512 + hh * 128;
#pragma unroll
        for (int i = 0; i < 2; ++i) { const int cc = tid + 512 * i; const int r = cc >> 4, c16 = cc & 15; *(LAS u32x4*)(II + r * 272 + c16 * 16) = *(const u32x4*)(IH + (size_t)r * 512 + c16 * 8); }
    }
    float qv[16];
    {
        const u16* QH = (const u16*)(p.ws + OFF_QH) + (row0 + 16 * seg) * 512 + hh * 128 + d;
#pragma unroll
        for (int i = 0; i < 16; ++i) qv[i] = bf2f(QH[(size_t)i * 512]);
    }
    chunk_cumsum((const float*)(p.ws + OFF_G) + (row0 + 16 * seg) * 512 + hh * 128 + d, gv, bc, segsum, d, seg, off, tot);
#pragma unroll
    for (int i = 0; i < 16; ++i) {
        const float bb = off + bc[i];
        const int s = 16 * seg + i;
        *(LAS u16*)(QE + s * 272 + d * 2) = bf1(qv[i] * __expf(bb));
        *(LAS u16*)(KE + s * 272 + d * 2) = bf1((1.f - __expf(gv[i])) * __expf(fminf(-bb, 80.f)));
    }
    __syncthreads();
    const int col = lane & 31, h = lane >> 5, gi = (lane >> 4) & 1, i16 = lane & 15, tq = i16 >> 2, tp = i16 & 3;
    const int vi = wid & 3, ti = wid >> 2;
    bf16x8 qf[8];
#pragma unroll
    for (int kd = 0; kd < 8; ++kd) qf[kd] = *(const LAS bf16x8*)(QE + (32 * ti + col) * 272 + (16 * kd + 8 * h) * 2);
    f32x16 o;
#pragma unroll
    for (int i = 0; i < 16; ++i) o[i] = 0.f;
    {
        const u16* S0 = (const u16*)(p.ws + OFF_SLOC) + (size_t)ch * 16384 + (size_t)(32 * vi + col) * 128 + 8 * h;
        bf16x8 sa[8];
#pragma unroll
        for (int kd = 0; kd < 8; ++kd) sa[kd] = *(const bf16x8*)(S0 + 16 * kd);
#pragma unroll
        for (int kd = 0; kd < 8; ++kd) o = MFMA32(sa[kd], qf[kd], o);
    }
#pragma unroll
    for (int si = 0; si < 2; ++si) {
        if (si <= ti) {
            f32x16 pt;
#pragma unroll
            for (int i = 0; i < 16; ++i) pt[i] = 0.f;
#pragma unroll
            for (int kd = 0; kd < 8; ++kd) { const bf16x8 ka = *(const LAS bf16x8*)(KE + (32 * si + col) * 272 + (16 * kd + 8 * h) * 2); pt = MFMA32(ka, qf[kd], pt); }
            float w[16];
#pragma unroll
            for (int i = 0; i < 16; ++i) w[i] = (si < ti || crow(i, h) <= col) ? pt[i] : 0.f;
            const bf16x8 pw0 = pack8(w), pw1 = pack8(w + 8);
#pragma unroll
            for (int s2 = 0; s2 < 2; ++s2) {
                LAS unsigned char* lo = II + (32 * si + 16 * s2 + 4 * h + tq) * 272 + (32 * vi + 16 * gi + 4 * tp) * 2;
                const bf16x8 A = tr2(lo, lo + 8 * 272);
                o = MFMA32(A, s2 ? pw1 : pw0, o);
            }
        }
    }
    {
        float ss = 0.f;
#pragma unroll
        for (int i = 0; i < 16; ++i) ss += o[i] * o[i];
        ss += __shfl_xor(ss, 32);
        if (h == 0) ssq[(32 * ti + col) * 4 + vi] = ss;
    }
    __syncthreads();
    {
        const int t = 32 * ti + col;
        const float tot2 = (ssq[t * 4] + ssq[t * 4 + 1]) + (ssq[t * 4 + 2] + ssq[t * 4 + 3]);
        const float rs = rsqrtf(tot2 * (1.f / 128.f) + 1e-6f);
        const size_t row = row0 + t;
        const u16* GH = (const u16*)(p.ws + OFF_GH) + row * 512 + hh * 128 + 32 * vi;
        u16* MX = (u16*)(p.ws + OFF_XB) + row * 1024 + 512 + hh * 128 + 32 * vi;
#pragma unroll
        for (int g4 = 0; g4 < 4; ++g4) {
            const int v0 = 8 * g4 + 4 * h;
            const u32x2 gh = *(const u32x2*)(GH + v0);
            u32x2 wv; wv[0] = pk_bf16(o[4 * g4] * rs * bflo(gh[0]), o[4 * g4 + 1] * rs * bfhi(gh[0])); wv[1] = pk_bf16(o[4 * g4 + 2] * rs * bflo(gh[1]), o[4 * g4 + 3] * rs * bfhi(gh[1]));
            *(u32x2*)(MX + v0) = wv;
        }
    }
}

DI void sample_hgrn(const P& p, int bh, unsigned char* shm) {
    const int tid = threadIdx.x, b = bh >> 2, hh = bh & 3;
    float* F = (float*)shm; float* Q = F + 2048; float* I = Q + 2048; float* PART = I + 2048; float* O = PART + 512;
    for (int e = tid; e < 2048; e += 512) {
        const int t = e >> 7, c = e & 127; const size_t off = (size_t)(NP + b * 16 + t) * 512 + hh * 128 + c;
        F[e] = __expf(((const float*)(p.ws + OFF_G))[off]); Q[e] = bf2f(((const u16*)(p.ws + OFF_QH))[off]); I[e] = bf2f(((const u16*)(p.ws + OFF_IH))[off]);
    }
    const int v = tid & 127, dq = tid >> 7;
    float S[32];
#pragma unroll
    for (int dd = 0; dd < 32; ++dd) S[dd] = p.state_s[((size_t)bh * 128 + 32 * dq + dd) * 128 + v];
    __syncthreads();
    for (int t = 0; t < 16; ++t) {
        const float iv = I[t * 128 + v]; float po = 0.f;
#pragma unroll
        for (int dd = 0; dd < 32; ++dd) { const float f = F[t * 128 + 32 * dq + dd], q = Q[t * 128 + 32 * dq + dd]; S[dd] = f * S[dd] + (1.f - f) * iv; po += S[dd] * q; }
        PART[dq * 128 + v] = po;
        __syncthreads();
        if (dq == 0) O[t * 128 + v] = (PART[v] + PART[128 + v]) + (PART[256 + v] + PART[384 + v]);
        __syncthreads();
    }
#pragma unroll
    for (int dd = 0; dd < 32; ++dd) p.out[O_SS + ((size_t)bh * 128 + 32 * dq + dd) * 128 + v] = S[dd];
    {
        const int t = tid >> 5, l32 = tid & 31;
        const float4 o = *(const float4*)(O + t * 128 + l32 * 4);
        float ss = (o.x * o.x + o.y * o.y) + (o.z * o.z + o.w * o.w);
        ss += __shfl_xor(ss, 16); ss += __shfl_xor(ss, 8); ss += __shfl_xor(ss, 4); ss += __shfl_xor(ss, 2); ss += __shfl_xor(ss, 1);
        const float rs = rsqrtf(ss * (1.f / 128.f) + 1e-6f);
        const size_t row = (size_t)NP + b * 16 + t;
        const u32x2 gh = *(const u32x2*)((const u16*)(p.ws + OFF_GH) + row * 512 + hh * 128 + l32 * 4);
        u32x2 wv; wv[0] = pk_bf16(o.x * rs * bflo(gh[0]), o.y * rs * bfhi(gh[0])); wv[1] = pk_bf16(o.z * rs * bflo(gh[1]), o.w * rs * bfhi(gh[1]));
        *(u32x2*)((u16*)(p.ws + OFF_XB) + row * 1024 + 512 + hh * 128 + l32 * 4) = wv;
    }
}

__global__ void __launch_bounds__(512, 2) mega(P p) {
    extern __shared__ __attribute__((aligned(16))) unsigned char shm[];
    LAS unsigned char* L = (LAS unsigned char*)shm;
    cg::grid_group grid = cg::this_grid();
    const int wid = threadIdx.x >> 6, lane = threadIdx.x & 63;
    const bool multi = (p.ph_hi - p.ph_lo) > 1;
#define PH_ON(n) (p.ph_lo <= (n) && (n) < p.ph_hi && (PHMASK & (1 << (n))))
#define PH_SYNC(n) do { if (multi && p.ph_lo <= (n) && (n) + 1 < p.ph_hi) grid.sync(); } while (0)
    if (PH_ON(0)) phase0(p, shm);
    PH_SYNC(0);
    if (PH_ON(1)) {
        pg8::StaticOrder S; S.init(MPAD, 4096, (int)gridDim.x, (int)blockIdx.x);
        pg8::Gemm g; g.A = (const u16*)(p.ws + OFF_XB); g.Bt = (const u16*)(p.ws + OFF_WINT); g.M = MPAD; g.N = 4096; g.K = 1024;
        EpiProj E; E.p = p;
        pg8::gemm_phase<EpiProj, pg8::StaticOrder>(L, g, S, E);
    }
    PH_SYNC(1);
    if (PH_ON(2)) {
        for (int it = blockIdx.x; it < 1576; it += gridDim.x) {
            __syncthreads();
            if (it < 32) sample_hgrn(p, it, shm);
            else if (it < 40) attn_wave<true>(p, (it - 32) * 8 + wid, L + wid * 4608, lane);
            else if (it < 552) attn_wave<false>(p, (it - 40) * 8 + wid, L + wid * 4608, lane);
            else hgrn_local(p, it - 552, L);
        }
    }
    PH_SYNC(2);
    if (PH_ON(3)) {
        if (blockIdx.x < 4) {
            pg8::SingleUnit S; S.pm = 64; S.pn = (int)blockIdx.x;
            pg8::Gemm g; g.A = (const u16*)(p.ws + OFF_XB); g.Bt = (const u16*)(p.ws + OFF_WOUTT); g.M = MPAD; g.N = 1024; g.K = 1024;
            EpiLN E; E.p = p;
            pg8::gemm_phase<EpiLN, pg8::SingleUnit>(L, g, S, E);
        } else {
            hgrn_scan(p, 4);
        }
    }
    PH_SYNC(3);
    if (PH_ON(4)) {
        for (int it = blockIdx.x; it < 1024; it += gridDim.x) { __syncthreads(); hgrn_out(p, it, L); }
    }
    PH_SYNC(4);
    if (PH_ON(5)) {
        pg8::SingleUnit S; S.pm = (int)blockIdx.x & 63; S.pn = (int)blockIdx.x >> 6;
        pg8::Gemm g; g.A = (const u16*)(p.ws + OFF_XB); g.Bt = (const u16*)(p.ws + OFF_WOUTT); g.M = MPAD; g.N = 1024; g.K = 1024;
        EpiLN E; E.p = p;
        pg8::gemm_phase<EpiLN, pg8::SingleUnit>(L, g, S, E);
    }
}

extern "C" void kernel_launch(void* const* d_in, const int* in_sizes, int n_in, void* d_out, int out_size, void* d_ws, size_t ws_size, hipStream_t stream) {
    static int grid = 0;
    if (grid == 0) {
        int dev = 0, cus = 0, per_cu = 0;
        hipGetDevice(&dev);
        hipDeviceGetAttribute(&cus, hipDeviceAttributeMultiprocessorCount, dev);
        hipFuncSetAttribute((const void*)mega, hipFuncAttributeMaxDynamicSharedMemorySize, LDS_BYTES);
        hipOccupancyMaxActiveBlocksPerMultiprocessor(&per_cu, (const void*)mega, 512, LDS_BYTES);
        grid = cus * per_cu;
        if (grid > 256) grid = 256;
        if (grid != 256 || ws_size < WS_END) { fprintf(stderr, "kernel_launch: needs 256 co-resident workgroups (got %d x %d) and %zu B of workspace (got %zu)\n", cus, per_cu, (size_t)WS_END, ws_size); }
    }
    hipMemsetAsync((unsigned char*)d_ws + OFF_CTR, 0, SZ_CTR, stream);
    P p{};
    p.x_prompt = (const float*)d_in[0]; p.x_sample = (const float*)d_in[1]; p.cache_k = (const float*)d_in[2]; p.cache_v = (const float*)d_in[3];
    p.state_s = (const float*)d_in[4]; p.w_in = (const float*)d_in[5]; p.w_out = (const float*)d_in[6]; p.lb_logits = (const float*)d_in[7];
    p.norm_g = (const float*)d_in[8]; p.ln_g = (const float*)d_in[9]; p.ln_b = (const float*)d_in[10];
    p.out = (float*)d_out; p.ws = (unsigned char*)d_ws; p.ph_lo = 0; p.ph_hi = 6;
    void* args[] = {&p};
    hipError_t e = hipLaunchCooperativeKernel((const void*)mega, dim3(grid), dim3(512), args, LDS_BYTES, stream);
    if (e != hipSuccess) fprintf(stderr, "cooperative launch failed: %s (grid %d)\n", hipGetErrorString(e), grid);
}
```

```cpp
#include <hip/hip_runtime.h>
#include <hip/hip_cooperative_groups.h>
#include <cstdio>
namespace cg = cooperative_groups;

#define DI __device__ __forceinline__
#define LAS __attribute__((address_space(3)))
typedef unsigned short u16;
typedef short bf16x8 __attribute__((ext_vector_type(8)));
typedef short s16x4 __attribute__((ext_vector_type(4)));
typedef float f32x4 __attribute__((ext_vector_type(4)));
typedef float f32x2 __attribute__((ext_vector_type(2)));
typedef float f32x16 __attribute__((ext_vector_type(16)));
typedef unsigned u32x4 __attribute__((ext_vector_type(4)));
typedef unsigned u32x2 __attribute__((ext_vector_type(2)));
typedef __bf16 bf16x2_t __attribute__((ext_vector_type(2)));

constexpr int NP = 16384;
constexpr int NTOK = 16512;
constexpr int MPAD = 16640;
constexpr float ALPHA = 1.189207115002721f;
constexpr float QSCALE = 0.18033688011112042f;
constexpr float RSTOP = 150.0f;

constexpr size_t O_YP = 0, O_YS = 16777216, O_KP = 16908288, O_VP = 25296896, O_SP = 33685504, O_KS = 34209792, O_VS = 34275328, O_SS = 34340864;

constexpr size_t SZ_XB = (size_t)MPAD * 1024 * 2;
constexpr size_t SZ_H = (size_t)MPAD * 512 * 2;
constexpr size_t OFF_XB = 0;
constexpr size_t OFF_WINT = OFF_XB + SZ_XB;
constexpr size_t OFF_WOUTT = OFF_WINT + (size_t)4096 * 1024 * 2;
constexpr size_t OFF_QA = OFF_WOUTT + (size_t)1024 * 1024 * 2;
constexpr size_t OFF_KA = OFF_QA + SZ_H;
constexpr size_t OFF_VA = OFF_KA + SZ_H;
constexpr size_t OFF_GA = OFF_VA + SZ_H;
constexpr size_t OFF_QH = OFF_GA + SZ_H;
constexpr size_t OFF_IH = OFF_QH + SZ_H;
constexpr size_t OFF_GH = OFF_IH + SZ_H;
constexpr size_t OFF_G = OFF_GH + SZ_H;
constexpr size_t OFF_SLOC = OFF_G + (size_t)MPAD * 512 * 4;
constexpr size_t OFF_BLAST = OFF_SLOC + (size_t)1024 * 16384 * 2;
constexpr size_t OFF_STATS = OFF_BLAST + (size_t)1024 * 128 * 4;
constexpr size_t OFF_CTR = OFF_STATS + (size_t)65 * 4 * 256 * 2 * 4;
constexpr size_t SZ_CTR = 65 * 64 * 4;
constexpr size_t OFF_PRE = OFF_CTR + 16896;
constexpr size_t WS_END = OFF_PRE + (size_t)128 * 1024 * 4;
constexpr int LDS_BYTES = 131072;
#ifndef PHMASK
#define PHMASK 63
#endif
#ifndef REP_PH
#define REP_PH -1
#endif
#define REPS(n) for (int rep_ = 0; rep_ < ((n) == REP_PH ? 2 : 1); ++rep_)

struct P {
    const float *x_prompt, *x_sample, *cache_k, *cache_v, *state_s, *w_in, *w_out, *lb_logits, *norm_g, *ln_g, *ln_b;
    float* out;
    unsigned char* ws;
    int ph_lo, ph_hi;
};

DI unsigned pk_bf16(float lo, float hi) { f32x2 v = {lo, hi}; bf16x2_t b = __builtin_convertvector(v, bf16x2_t); return __builtin_bit_cast(unsigned, b); }
DI u16 bf1(float x) { return (u16)(pk_bf16(x, 0.f) & 0xffffu); }
DI float bf2f(u16 v) { return __uint_as_float(((unsigned)v) << 16); }
DI float bflo(unsigned v) { return __uint_as_float(v << 16); }
DI float bfhi(unsigned v) { return __uint_as_float(v & 0xffff0000u); }
DI float ex2(float x) { return __builtin_amdgcn_exp2f(x); }
DI float lg2(float x) { return __builtin_amdgcn_logf(x); }
DI float sigm(float x) { return 1.f / (1.f + __expf(-x)); }
DI float silu(float x) { return x / (1.f + __expf(-x)); }
DI int otid() { int t = threadIdx.x; asm volatile("" : "+v"(t)); return t; }
DI int crow(int i, int h) { return (i & 3) + 8 * (i >> 2) + 4 * h; }
DI bf16x8 pack8(const float* w) { u32x4 r; r[0] = pk_bf16(w[0], w[1]); r[1] = pk_bf16(w[2], w[3]); r[2] = pk_bf16(w[4], w[5]); r[3] = pk_bf16(w[6], w[7]); return __builtin_bit_cast(bf16x8, r); }
DI bf16x8 pack8v(float4 a, float4 b) { u32x4 r; r[0] = pk_bf16(a.x, a.y); r[1] = pk_bf16(a.z, a.w); r[2] = pk_bf16(b.x, b.y); r[3] = pk_bf16(b.z, b.w); return __builtin_bit_cast(bf16x8, r); }
DI bf16x8 tr2(LAS unsigned char* lo, LAS unsigned char* hi) {
    s16x4 a = __builtin_amdgcn_ds_read_tr16_b64_v4i16((LAS s16x4*)lo);
    s16x4 b = __builtin_amdgcn_ds_read_tr16_b64_v4i16((LAS s16x4*)hi);
    return __builtin_shufflevector(a, b, 0, 1, 2, 3, 4, 5, 6, 7);
}
#define MFMA32(a, b, c) __builtin_amdgcn_mfma_f32_32x32x16_bf16((a), (b), (c), 0, 0, 0)

namespace pg8 {
constexpr int BM = 256, BK = 64, HALF = 128, HTB = HALF * BK * 2, STAGE_BYTES = 8 * HTB, NXCD = 8, WGM = 8;
DI int lds_byte(int r, int c) { const int st = (r >> 4) * 2 + (c >> 5), rr = r & 15, cc = c & 31, ob = rr * 64 + cc * 2; return st * 1024 + (ob ^ (((ob >> 9) & 1) << 5)); }
DI void stage_rc(int b, int& R, int& C) { const int st = b / 1024, sb = b % 1024, swz = sb ^ (((sb >> 9) & 1) << 5); R = (st >> 1) * 16 + swz / 64; C = (st & 1) * 32 + (swz % 64) / 2; }
struct Unit { int pm, pn; };
struct Gemm { const u16* A; const u16* Bt; int M, N, K; };
struct StaticOrder {
    int nM, nN, nwg, G, c;
    DI void init(int M, int N, int G_, int c_) { nM = M / BM; nN = N / BM; nwg = nM * nN; G = G_; c = c_; }
    DI bool next(int i, Unit& u) const {
        const long L = (long)i * G + c; if (L >= nwg) return false;
        int wgid = (int)L; { const int q = nwg / NXCD, r = nwg % NXCD, xcd = wgid % NXCD, off = wgid / NXCD; wgid = (xcd < r ? xcd * (q + 1) : r * (q + 1) + (xcd - r) * q) + off; }
        const int nig = WGM * nN, gid = wgid / nig, fm = gid * WGM, gsz = (nM - fm) < WGM ? (nM - fm) : WGM;
        u.pm = fm + ((wgid % nig) % gsz); u.pn = (wgid % nig) / gsz; return true;
    }
};
struct SingleUnit {
    int pm, pn;
    DI bool next(int i, Unit& u) const { if (i) return false; u.pm = pm; u.pn = pn; return true; }
};

template <class Epi, class Sched>
DI void gemm_phase(LAS unsigned char* lds, const Gemm g, const Sched& S, const Epi& E) {
    const int tid = otid(), wid = __builtin_amdgcn_readfirstlane(tid >> 6), lane = tid & 63, wr = wid >> 2, wc = wid & 3, fr = lane & 15, fq = lane >> 4;
    const int K = g.K, nt = K / BK;
    unsigned voffA[2], voffB[2];
#pragma unroll
    for (int i = 0; i < 2; ++i) { int R, C; stage_rc(tid * 16 + i * 8192, R, C); voffA[i] = (unsigned)(R * K + C) * 2u; voffB[i] = voffA[i]; }
    const size_t kstep = (size_t)(BK * 2);
    const size_t hstep = (size_t)HALF * K * 2;
    const size_t tstep = 2 * hstep;
    const unsigned ldsw = (unsigned)wid * 1024u;
    const int aoff = lds_byte(wr * 64 + fr, fq * 8), boff = lds_byte(wc * 32 + fr, fq * 8);
#define PG8_SA(b, h) (((b) * 2 + (h)) * HTB)
#define PG8_SB(b, h) ((4 + (b) * 2 + (h)) * HTB)
#define PG8_STAGE(bufoff, gbase, voff) do { _Pragma("unroll") for (int _i = 0; _i < 2; ++_i) \
        __builtin_amdgcn_global_load_lds((const unsigned*)((const char*)(gbase) + (voff)[_i]), (LAS unsigned*)(lds + (bufoff) + ldsw + _i * 8192), 16, 0, 0); } while (0)
#define PG8_LDA(dst, b, h) do { _Pragma("unroll") for (int m = 0; m < 4; ++m) _Pragma("unroll") for (int k = 0; k < 2; ++k) dst[m][k] = *(const LAS bf16x8*)(lds + PG8_SA(b, h) + aoff + m * 2048 + k * 1024); } while (0)
#define PG8_LDB(dst, b, h) do { _Pragma("unroll") for (int n = 0; n < 2; ++n) _Pragma("unroll") for (int k = 0; k < 2; ++k) dst[n][k] = *(const LAS bf16x8*)(lds + PG8_SB(b, h) + boff + n * 2048 + k * 1024); } while (0)
#define PG8_MMA(ai, bj, At, Bt) do { __builtin_amdgcn_s_setprio(1); _Pragma("unroll") for (int m = 0; m < 4; ++m) _Pragma("unroll") for (int n = 0; n < 2; ++n) _Pragma("unroll") for (int k = 0; k < 2; ++k) \
        acc[ai][bj][m][n] = __builtin_amdgcn_mfma_f32_16x16x32_bf16(Bt[n][k], At[m][k], acc[ai][bj][m][n], 0, 0, 0); __builtin_amdgcn_s_setprio(0); } while (0)
#define PG8_WAIT_V(n) asm volatile("s_waitcnt vmcnt(" #n ")" ::: "memory")
#define PG8_WAIT_L(n) asm volatile("s_waitcnt lgkmcnt(" #n ")" ::: "memory")
#define PG8_BAR __builtin_amdgcn_s_barrier()
#define PG8_SCHED __builtin_amdgcn_sched_barrier(0)
    Unit cur, nxt; int ui = 0;
    if (!S.next(0, cur)) return;
    f32x4 acc[2][2][4][2];
#pragma unroll
    for (int a = 0; a < 2; ++a)
#pragma unroll
        for (int b = 0; b < 2; ++b)
#pragma unroll
            for (int m = 0; m < 4; ++m)
#pragma unroll
                for (int n = 0; n < 2; ++n) acc[a][b][m][n] = (f32x4){0.f, 0.f, 0.f, 0.f};
    bf16x8 At[4][2], B0[2][2], B1[2][2];
    const char* cA = (const char*)g.A + (size_t)cur.pm * tstep; const char* cB = (const char*)g.Bt + (size_t)cur.pn * tstep;
    PG8_STAGE(PG8_SB(0, 0), cB, voffB); PG8_STAGE(PG8_SA(0, 0), cA, voffA); PG8_STAGE(PG8_SB(0, 1), cB + hstep, voffB); PG8_STAGE(PG8_SA(0, 1), cA + hstep, voffA);
    if (wr == 1) PG8_BAR;
    PG8_WAIT_V(4); PG8_BAR;
    PG8_STAGE(PG8_SB(1, 0), cB + kstep, voffB); PG8_STAGE(PG8_SA(1, 0), cA + kstep, voffA); PG8_STAGE(PG8_SB(1, 1), cB + hstep + kstep, voffB);
    PG8_WAIT_V(6); PG8_BAR;
    for (;;) {
        const bool has_next = S.next(ui + 1, nxt);
        const char* nA = has_next ? (const char*)g.A + (size_t)nxt.pm * tstep : cA; const char* nB = has_next ? (const char*)g.Bt + (size_t)nxt.pn * tstep : cB;
        for (int t = 0; t < nt; t += 2) {
            const bool last = (t == nt - 2);
            const char* a1 = cA + (size_t)(t + 1) * kstep;
            const char* a2 = last ? nA : cA + (size_t)(t + 2) * kstep; const char* b2 = last ? nB : cB + (size_t)(t + 2) * kstep;
            const char* a3 = a2 + kstep; const char* b3 = b2 + kstep;
            PG8_LDB(B0, 0, 0); PG8_SCHED; PG8_LDA(At, 0, 0); PG8_STAGE(PG8_SA(1, 1), a1 + hstep, voffA);
            PG8_WAIT_L(8); PG8_BAR; PG8_WAIT_L(0); PG8_MMA(0, 0, At, B0); PG8_BAR; PG8_SCHED;
            PG8_LDB(B1, 0, 1); PG8_STAGE(PG8_SB(0, 0), b2, voffB);
            PG8_BAR; PG8_WAIT_L(0); PG8_MMA(0, 1, At, B1); PG8_BAR;
            PG8_LDA(At, 0, 1); PG8_STAGE(PG8_SA(0, 0), a2, voffA);
            PG8_BAR; PG8_WAIT_L(0); PG8_MMA(1, 0, At, B0); PG8_BAR; PG8_SCHED;
            PG8_STAGE(PG8_SB(0, 1), b2 + hstep, voffB);
            PG8_WAIT_V(6); PG8_BAR; PG8_MMA(1, 1, At, B1); PG8_BAR;
            PG8_LDB(B0, 1, 0); PG8_SCHED; PG8_LDA(At, 1, 0); PG8_STAGE(PG8_SA(0, 1), a2 + hstep, voffA);
            PG8_WAIT_L(8); PG8_BAR; PG8_WAIT_L(0); PG8_MMA(0, 0, At, B0); PG8_BAR; PG8_SCHED;
            PG8_LDB(B1, 1, 1); PG8_STAGE(PG8_SB(1, 0), b3, voffB);
            PG8_BAR; PG8_WAIT_L(0); PG8_MMA(0, 1, At, B1); PG8_BAR;
            PG8_LDA(At, 1, 1); PG8_STAGE(PG8_SA(1, 0), a3, voffA);
            PG8_BAR; PG8_WAIT_L(0); PG8_MMA(1, 0, At, B0); PG8_BAR; PG8_SCHED;
            PG8_STAGE(PG8_SB(1, 1), b3 + hstep, voffB);
            PG8_WAIT_V(6); PG8_BAR; PG8_MMA(1, 1, At, B1); PG8_BAR;
        }
        if constexpr (!Epi::AFTER_DRAIN) { int fr2 = fr, fq2 = fq, wr2 = wr, wc2 = wc; asm volatile("" : "+v"(fr2), "+v"(fq2), "+s"(wr2), "+s"(wc2)); E(acc, cur, wr2, wc2, fr2, fq2); }
        if (!has_next) break;
#pragma unroll
        for (int a = 0; a < 2; ++a)
#pragma unroll
            for (int b = 0; b < 2; ++b)
#pragma unroll
                for (int m = 0; m < 4; ++m)
#pragma unroll
                    for (int n = 0; n < 2; ++n) acc[a][b][m][n] = (f32x4){0.f, 0.f, 0.f, 0.f};
        cur = nxt; cA = nA; cB = nB; ++ui;
    }
    PG8_WAIT_V(0);
    if (wr == 0) PG8_BAR;
    PG8_BAR;
    if constexpr (Epi::AFTER_DRAIN) { int fr2 = fr, fq2 = fq, wr2 = wr, wc2 = wc, tid2 = tid; asm volatile("" : "+v"(fr2), "+v"(fq2), "+s"(wr2), "+s"(wc2), "+v"(tid2)); E.fused(acc, cur, wr2, wc2, fr2, fq2, lds, tid2); }
#undef PG8_SA
#undef PG8_SB
#undef PG8_STAGE
#undef PG8_LDA
#undef PG8_LDB
#undef PG8_MMA
#undef PG8_WAIT_V
#undef PG8_WAIT_L
#undef PG8_BAR
#undef PG8_SCHED
}
}

template <int SEG> DI f32x4 proj_aux(const P& p, int cc) {
    f32x4 a = {0.f, 0.f, 0.f, 0.f};
    if constexpr (SEG == 5) {
        const f32x4 l0 = *(const f32x4*)(p.lb_logits + cc), l1 = *(const f32x4*)(p.lb_logits + 512 + cc);
#pragma unroll
        for (int j = 0; j < 4; ++j) a[j] = 1.f / (1.f + __expf(l1[j] - l0[j]));
    }
    if constexpr (SEG == 7) a = *(const f32x4*)(p.norm_g + cc);
    return a;
}
template <int SEG> DI void proj_store(const P& p, int row, int cc, f32x4 v, f32x4 aux) {
    unsigned char* ws = p.ws;
    if constexpr (SEG == 5) {
        f32x4 g;
#pragma unroll
        for (int j = 0; j < 4; ++j) { const float lb = aux[j]; g[j] = __logf(lb + (1.f - lb) * sigm(v[j])); }
        *(f32x4*)((float*)(ws + OFF_G) + (size_t)row * 512 + cc) = g;
    } else {
        if constexpr (SEG == 1 || SEG == 2) {
            const int hd = cc >> 6, d = cc & 63;
            float* o;
            if (row < NP) { const int b = row >> 11, t = row & 2047; o = p.out + (SEG == 1 ? O_KP : O_VP) + ((size_t)((b * 8 + hd) * 2048 + t)) * 64 + d; }
            else { const int rs = row - NP, b = rs >> 4, t = rs & 15; o = p.out + (SEG == 1 ? O_KS : O_VS) + ((size_t)((b * 8 + hd) * 16 + t)) * 64 + d; }
            *(f32x4*)o = v;
        }
        if constexpr (SEG == 0) { v = v * QSCALE; }
        if constexpr (SEG == 3 || SEG == 4) {
#pragma unroll
            for (int j = 0; j < 4; ++j) v[j] = silu(v[j]);
        }
        if constexpr (SEG == 7) {
#pragma unroll
            for (int j = 0; j < 4; ++j) v[j] = silu(v[j]) * aux[j];
        }
        constexpr size_t off = SEG == 0 ? OFF_QA : SEG == 1 ? OFF_KA : SEG == 2 ? OFF_VA : SEG == 3 ? OFF_GA : SEG == 4 ? OFF_QH : SEG == 6 ? OFF_IH : OFF_GH;
        u32x2 w; w[0] = pk_bf16(v[0], v[1]); w[1] = pk_bf16(v[2], v[3]);
        *(u32x2*)((u16*)(ws + off) + (size_t)row * 512 + cc) = w;
    }
}
struct EpiProj {
    static constexpr bool PERM = false, AFTER_DRAIN = false;
    P p;
    template <int SEG>
    DI void seg(const f32x4 (&acc)[2][2][4][2], const pg8::Unit& u, int wr, int wc, int fr, int fq) const {
        const int colt = (u.pn & 1) * 256 + wc * 32 + 4 * fq;
        f32x4 aux[2][2];
#pragma unroll
        for (int bj = 0; bj < 2; ++bj)
#pragma unroll
            for (int n = 0; n < 2; ++n) aux[bj][n] = proj_aux<SEG>(p, colt + bj * 128 + n * 16);
#pragma unroll
        for (int ai = 0; ai < 2; ++ai)
#pragma unroll
            for (int m = 0; m < 4; ++m) {
                const int row = u.pm * 256 + ai * 128 + wr * 64 + m * 16 + fr;
#pragma unroll
                for (int bj = 0; bj < 2; ++bj)
#pragma unroll
                    for (int n = 0; n < 2; ++n) proj_store<SEG>(p, row, colt + bj * 128 + n * 16, acc[ai][bj][m][n], aux[bj][n]);
            }
    }
    DI void operator()(const f32x4 (&acc)[2][2][4][2], const pg8::Unit& u, int wr, int wc, int fr, int fq) const {
        switch (u.pn >> 1) {
            case 0: seg<0>(acc, u, wr, wc, fr, fq); break;
            case 1: seg<1>(acc, u, wr, wc, fr, fq); break;
            case 2: seg<2>(acc, u, wr, wc, fr, fq); break;
            case 3: seg<3>(acc, u, wr, wc, fr, fq); break;
            case 4: seg<4>(acc, u, wr, wc, fr, fq); break;
            case 5: seg<5>(acc, u, wr, wc, fr, fq); break;
            case 6: seg<6>(acc, u, wr, wc, fr, fq); break;
            default: seg<7>(acc, u, wr, wc, fr, fq); break;
        }
    }
};
DI f32x4 slice16(const u16* arow  , const u16* brow  ) {
    f32x4 acc = {0.f, 0.f, 0.f, 0.f};
#pragma unroll 8
    for (int k0 = 0; k0 < 1024; k0 += 32) acc = __builtin_amdgcn_mfma_f32_16x16x32_bf16(*(const bf16x8*)(brow + k0), *(const bf16x8*)(arow + k0), acc, 0, 0, 0);
    return acc;
}
DI void sample_proj(const P& p) {
    const int tid_ = otid(); const int lane = tid_ & 63, wid = tid_ >> 6, fr = lane & 15, fq = lane >> 4;
    for (int cb = blockIdx.x; cb < 256; cb += gridDim.x) {
        const int row = NP + 16 * wid + fr;
        const f32x4 acc = slice16((const u16*)(p.ws + OFF_XB) + (size_t)row * 1024 + 8 * fq, (const u16*)(p.ws + OFF_WINT) + (size_t)(16 * cb + fr) * 1024 + 8 * fq);
        const int cc = ((16 * cb) & 511) + 4 * fq;
        switch (cb >> 5) {
            case 0: proj_store<0>(p, row, cc, acc, proj_aux<0>(p, cc)); break;
            case 1: proj_store<1>(p, row, cc, acc, proj_aux<1>(p, cc)); break;
            case 2: proj_store<2>(p, row, cc, acc, proj_aux<2>(p, cc)); break;
            case 3: proj_store<3>(p, row, cc, acc, proj_aux<3>(p, cc)); break;
            case 4: proj_store<4>(p, row, cc, acc, proj_aux<4>(p, cc)); break;
            case 5: proj_store<5>(p, row, cc, acc, proj_aux<5>(p, cc)); break;
            case 6: proj_store<6>(p, row, cc, acc, proj_aux<6>(p, cc)); break;
            default: proj_store<7>(p, row, cc, acc, proj_aux<7>(p, cc)); break;
        }
    }
}

struct EpiLN {
    static constexpr bool PERM = false, AFTER_DRAIN = true;
    P p;
    DI void fused(f32x4 (&acc)[2][2][4][2], const pg8::Unit& u, int wr, int wc, int fr, int fq, LAS unsigned char* lds, int tid) const {
        LAS float* red = (LAS float*)lds;
        LAS float* rowstat = (LAS float*)(lds + 8192);
        float* stats = (float*)(p.ws + OFF_STATS);
        unsigned* ctr = (unsigned*)(p.ws + OFF_CTR) + u.pm * 64;
        const int col0 = u.pn * 256 + wc * 32 + 4 * fq;
#pragma unroll
        for (int ai = 0; ai < 2; ++ai)
#pragma unroll
            for (int m = 0; m < 4; ++m) {
                const int rl = ai * 128 + wr * 64 + m * 16 + fr, row = u.pm * 256 + rl;
                const float* xr = row < NP ? p.x_prompt + (size_t)row * 1024 : p.x_sample + (size_t)((row < NTOK ? row : NP) - NP) * 1024;
                float a1 = 0.f, a2 = 0.f;
#pragma unroll
                for (int bj = 0; bj < 2; ++bj)
#pragma unroll
                    for (int n = 0; n < 2; ++n) {
                        const f32x4 xv = *(const f32x4*)(xr + col0 + bj * 128 + n * 16);
                        const f32x4 v = xv * ALPHA + acc[ai][bj][m][n];
                        acc[ai][bj][m][n] = v;
                        a1 += (v[0] + v[1]) + (v[2] + v[3]);
                        a2 += (v[0] * v[0] + v[1] * v[1]) + (v[2] * v[2] + v[3] * v[3]);
                    }
                a1 += __shfl_xor(a1, 16); a2 += __shfl_xor(a2, 16);
                a1 += __shfl_xor(a1, 32); a2 += __shfl_xor(a2, 32);
                if (fq == 0) { red[(rl * 4 + wc) * 2] = a1; red[(rl * 4 + wc) * 2 + 1] = a2; }
                if (m & 1) asm volatile("" ::: "memory");
            }
        __syncthreads();
        if (tid < 256) {
            float s1 = 0.f, s2 = 0.f;
#pragma unroll
            for (int w = 0; w < 4; ++w) { s1 += red[(tid * 4 + w) * 2]; s2 += red[(tid * 4 + w) * 2 + 1]; }
            float* dst = stats + ((size_t)(u.pm * 4 + u.pn) * 256 + tid) * 2;
            __hip_atomic_store(dst, s1, __ATOMIC_RELAXED, __HIP_MEMORY_SCOPE_AGENT);
            __hip_atomic_store(dst + 1, s2, __ATOMIC_RELAXED, __HIP_MEMORY_SCOPE_AGENT);
        }
        asm volatile("s_waitcnt vmcnt(0)" ::: "memory");
        __syncthreads();
        if (tid == 0) {
            __hip_atomic_fetch_add(ctr, 1u, __ATOMIC_RELAXED, __HIP_MEMORY_SCOPE_AGENT);
            while (__hip_atomic_load(ctr, __ATOMIC_RELAXED, __HIP_MEMORY_SCOPE_AGENT) < 4u) __builtin_amdgcn_s_sleep(1);
            __builtin_amdgcn_fence(__ATOMIC_ACQUIRE, "agent");
        }
        __syncthreads();
        if (tid < 256) {
            float s1 = 0.f, s2 = 0.f;
#pragma unroll
            for (int o = 0; o < 4; ++o) {
                const float* src = stats + ((size_t)(u.pm * 4 + o) * 256 + tid) * 2;
                s1 += __hip_atomic_load(src, __ATOMIC_RELAXED, __HIP_MEMORY_SCOPE_AGENT);
                s2 += __hip_atomic_load(src + 1, __ATOMIC_RELAXED, __HIP_MEMORY_SCOPE_AGENT);
            }
            const float mean = s1 * (1.f / 1024.f);
            const float var = fmaxf(s2 * (1.f / 1024.f) - mean * mean, 0.f);
            rowstat[tid * 2] = mean; rowstat[tid * 2 + 1] = rsqrtf(var + 1e-5f);
        }
        __syncthreads();
        f32x4 gv[2][2], bv[2][2];
#pragma unroll
        for (int bj = 0; bj < 2; ++bj)
#pragma unroll
            for (int n = 0; n < 2; ++n) { gv[bj][n] = *(const f32x4*)(p.ln_g + col0 + bj * 128 + n * 16); bv[bj][n] = *(const f32x4*)(p.ln_b + col0 + bj * 128 + n * 16); }
#pragma unroll
        for (int ai = 0; ai < 2; ++ai)
#pragma unroll
            for (int m = 0; m < 4; ++m) {
                const int rl = ai * 128 + wr * 64 + m * 16 + fr, row = u.pm * 256 + rl;
                if (row >= NTOK) continue;
                const float mean = rowstat[rl * 2], rstd = rowstat[rl * 2 + 1];
                float* yr = row < NP ? p.out + O_YP + (size_t)row * 1024 : p.out + O_YS + (size_t)(row - NP) * 1024;
#pragma unroll
                for (int bj = 0; bj < 2; ++bj)
#pragma unroll
                    for (int n = 0; n < 2; ++n) *(f32x4*)(yr + col0 + bj * 128 + n * 16) = (acc[ai][bj][m][n] - mean) * rstd * gv[bj][n] + bv[bj][n];
                asm volatile("" ::: "memory");
            }
    }
};

DI void phase0(const P& p, unsigned char* shm) {
    const int tid = otid(), nb = gridDim.x, bid = blockIdx.x;
    u16* XB = (u16*)(p.ws + OFF_XB);
    {
        u16* tile = (u16*)shm;
        float4 ta[5], tb[5];
        const int k = tid >> 3, n0 = (tid & 7) * 8;
#pragma unroll
        for (int i = 0; i < 5; ++i) {
            const int t = bid + i * nb;
            if (t < 1280) {
                const float* W; int N, kt, ntl;
                if (t < 1024) { W = p.w_in; N = 4096; kt = t >> 6; ntl = t & 63; } else { const int u = t - 1024; W = p.w_out; N = 1024; kt = u >> 4; ntl = u & 15; }
                const float4* s = (const float4*)(W + (size_t)(kt * 64 + k) * N + ntl * 64 + n0);
                ta[i] = s[0]; tb[i] = s[1];
            }
        }
#pragma unroll
        for (int i = 0; i < 5; ++i) {
            const int t = bid + i * nb;
            if (t < 1280) {
                u16* WT; int kt, ntl;
                if (t < 1024) { WT = (u16*)(p.ws + OFF_WINT); kt = t >> 6; ntl = t & 63; } else { const int u = t - 1024; WT = (u16*)(p.ws + OFF_WOUTT); kt = u >> 4; ntl = u & 15; }
                const float4 a = ta[i], b = tb[i];
                tile[(n0 + 0) * 66 + k] = bf1(a.x); tile[(n0 + 1) * 66 + k] = bf1(a.y); tile[(n0 + 2) * 66 + k] = bf1(a.z); tile[(n0 + 3) * 66 + k] = bf1(a.w);
                tile[(n0 + 4) * 66 + k] = bf1(b.x); tile[(n0 + 5) * 66 + k] = bf1(b.y); tile[(n0 + 6) * 66 + k] = bf1(b.z); tile[(n0 + 7) * 66 + k] = bf1(b.w);
                __syncthreads();
                const int n = tid >> 3, k0 = (tid & 7) * 8;
                const unsigned* r = (const unsigned*)(tile + n * 66 + k0);
                uint4 o; o.x = r[0]; o.y = r[1]; o.z = r[2]; o.w = r[3];
                *(uint4*)(WT + (size_t)(ntl * 64 + n) * 1024 + kt * 64 + k0) = o;
                __syncthreads();
            }
        }
    }
    const size_t n8p = (size_t)NP * 128, n8 = (size_t)NTOK * 128;
    const size_t stride = (size_t)nb * 512;
    for (size_t i0 = (size_t)bid * 512 + tid; i0 < n8; i0 += 4 * stride) {
        float4 a[4], b[4];
#pragma unroll
        for (int u = 0; u < 4; ++u) {
            const size_t i = i0 + u * stride;
            if (i < n8) { const float4* src = (i < n8p) ? ((const float4*)p.x_prompt + 2 * i) : ((const float4*)p.x_sample + 2 * (i - n8p)); a[u] = src[0]; b[u] = src[1]; }
        }
#pragma unroll
        for (int u = 0; u < 4; ++u) {
            const size_t i = i0 + u * stride;
            if (i < n8) { uint4 o; o.x = pk_bf16(a[u].x, a[u].y); o.y = pk_bf16(a[u].z, a[u].w); o.z = pk_bf16(b[u].x, b[u].y); o.w = pk_bf16(b[u].z, b[u].w); ((uint4*)XB)[i] = o; }
        }
    }
    for (int i = bid * 512 + tid; i < 16384; i += nb * 512) ((uint4*)(XB + (size_t)NTOK * 1024))[i] = make_uint4(0u, 0u, 0u, 0u);
}

template <bool SAMPLE>
DI void attn_wave(const P& p, int item, LAS unsigned char* vl, int lane) {
    const int col = lane & 31, h = lane >> 5;
    const int gi = (lane >> 4) & 1, i16 = lane & 15, tq = i16 >> 2, tp = i16 & 3;
    const u16* QA = (const u16*)(p.ws + OFF_QA);
    int b, hd, qt; size_t qrow;
    if (SAMPLE) { b = item >> 3; hd = item & 7; qt = 32; qrow = (size_t)NP + b * 16 + (col < 15 ? col : 15); }
    else { const int bh = item >> 6; qt = item & 63; b = bh >> 3; hd = bh & 7; qrow = (size_t)b * 2048 + 32 * qt + col; }
    const int qcol = SAMPLE ? (col < 15 ? col : 15) : col;
    bf16x8 qf[4];
#pragma unroll
    for (int s = 0; s < 4; ++s) qf[s] = *(const bf16x8*)(QA + qrow * 512 + hd * 64 + 16 * s + 8 * h);
    f32x16 o0, o1;
#pragma unroll
    for (int i = 0; i < 16; ++i) { o0[i] = 0.f; o1[i] = 0.f; }
    float R = 0.f;
    const u16* kbase = (const u16*)(p.ws + OFF_KA) + (size_t)b * 2048 * 512 + hd * 64;
    const u16* vbase = (const u16*)(p.ws + OFF_VA) + (size_t)b * 2048 * 512 + hd * 64;
    const float* ck = p.cache_k + (size_t)(b * 8 + hd) * 1024 * 64;
    const float* cv = p.cache_v + (size_t)(b * 8 + hd) * 1024 * 64;
    const float* nk = p.out + O_KS + (size_t)(b * 8 + hd) * 16 * 64;
    const float* nv = p.out + O_VS + (size_t)(b * 8 + hd) * 16 * 64;
    bf16x8 kn[4]; u32x4 vn[4];
    auto load_kv = [&](int j) {
        if (!SAMPLE) {
            const u16* kp = kbase + (size_t)(32 * j + col) * 512 + 8 * h;
#pragma unroll
            for (int s = 0; s < 4; ++s) kn[s] = *(const bf16x8*)(kp + 16 * s);
#pragma unroll
            for (int i = 0; i < 4; ++i) { const int c = lane + 64 * i; vn[i] = *(const u32x4*)(vbase + (size_t)(32 * j + (c >> 3)) * 512 + (c & 7) * 8); }
        } else {
            const bool fresh = (j == 32);
            const float* ksrc = fresh ? nk : ck; const float* vsrc = fresh ? nv : cv;
            const int r = fresh ? (col < 15 ? col : 15) : 32 * j + col;
            const float* kp = ksrc + (size_t)r * 64 + 8 * h;
#pragma unroll
            for (int s = 0; s < 4; ++s) kn[s] = pack8v(*(const float4*)(kp + 16 * s), *(const float4*)(kp + 16 * s + 4));
#pragma unroll
            for (int i = 0; i < 4; ++i) { const int c = lane + 64 * i; const int row = c >> 3; const int rr = fresh ? (row < 15 ? row : 15) : 32 * j + row;
                const float* vp = vsrc + (size_t)rr * 64 + (c & 7) * 8; const bf16x8 t8 = pack8v(*(const float4*)vp, *(const float4*)(vp + 4)); vn[i] = __builtin_bit_cast(u32x4, t8); }
        }
    };
    load_kv(qt);
    for (int j = qt; j >= 0; --j) {
        bf16x8 kf[4];
#pragma unroll
        for (int s = 0; s < 4; ++s) kf[s] = kn[s];
#pragma unroll
        for (int i = 0; i < 4; ++i) { const int c = lane + 64 * i; *(LAS u32x4*)(vl + (c >> 3) * 144 + (c & 7) * 16) = vn[i]; }
        if (j > 0) load_kv(j - 1);
        f32x16 st;
#pragma unroll
        for (int i = 0; i < 16; ++i) st[i] = 0.f;
#pragma unroll
        for (int s = 0; s < 4; ++s) st = MFMA32(kf[s], qf[s], st);
        const bool diag = (j == qt);
        float z[16], sp[16], w[16];
#pragma unroll
        for (int i = 0; i < 16; ++i) {
            const float zz = fminf(st[i], 126.f);
            float s_ = lg2(1.f + ex2(zz));
            if (diag && !(crow(i, h) < qcol)) s_ = 0.f;
            z[i] = zz; sp[i] = s_;
        }
        float Go[4], Gp[4];
#pragma unroll
        for (int m = 0; m < 4; ++m) { Go[m] = (sp[4 * m] + sp[4 * m + 1]) + (sp[4 * m + 2] + sp[4 * m + 3]); Gp[m] = __shfl_xor(Go[m], 32); }
        float base = R;
#pragma unroll
        for (int m = 3; m >= 0; --m) {
            const float bm = base + (h == 0 ? Gp[m] : 0.f);
            const float c3 = bm + sp[4 * m + 3], c2 = c3 + sp[4 * m + 2], c1 = c2 + sp[4 * m + 1], c0 = c1 + sp[4 * m];
            w[4 * m + 3] = ex2(z[4 * m + 3] - c3); w[4 * m + 2] = ex2(z[4 * m + 2] - c2); w[4 * m + 1] = ex2(z[4 * m + 1] - c1); w[4 * m] = ex2(z[4 * m] - c0);
            base += Go[m] + Gp[m];
        }
        R = base;
        if (diag) {
#pragma unroll
            for (int i = 0; i < 16; ++i) if (!(crow(i, h) < qcol)) w[i] = 0.f;
        }
        const bf16x8 pw0 = pack8(w), pw1 = pack8(w + 8);
#pragma unroll
        for (int s2 = 0; s2 < 2; ++s2) {
            LAS unsigned char* lo = vl + (16 * s2 + 4 * h + tq) * 144 + (16 * gi + 4 * tp) * 2;
            const bf16x8 a0 = tr2(lo, lo + 8 * 144);
            const bf16x8 a1 = tr2(lo + 64, lo + 8 * 144 + 64);
            o0 = MFMA32(a0, s2 ? pw1 : pw0, o0);
            o1 = MFMA32(a1, s2 ? pw1 : pw0, o1);
        }
        if (__all(R >= RSTOP)) break;
    }
    if (!SAMPLE || col < 16) {
        const size_t row = SAMPLE ? (size_t)NP + b * 16 + col : (size_t)b * 2048 + 32 * qt + col;
        const u16* GA = (const u16*)(p.ws + OFF_GA) + row * 512 + hd * 64;
        u16* MX = (u16*)(p.ws + OFF_XB) + row * 1024 + hd * 64;
#pragma unroll
        for (int dh = 0; dh < 2; ++dh)
#pragma unroll
            for (int g4 = 0; g4 < 4; ++g4) {
                const int d0 = 32 * dh + 8 * g4 + 4 * h;
                const u32x2 ga = *(const u32x2*)(GA + d0);
                const float v0 = (dh ? o1[4 * g4] : o0[4 * g4]) * bflo(ga[0]), v1 = (dh ? o1[4 * g4 + 1] : o0[4 * g4 + 1]) * bfhi(ga[0]);
                const float v2 = (dh ? o1[4 * g4 + 2] : o0[4 * g4 + 2]) * bflo(ga[1]), v3 = (dh ? o1[4 * g4 + 3] : o0[4 * g4 + 3]) * bfhi(ga[1]);
                u32x2 wv; wv[0] = pk_bf16(v0, v1); wv[1] = pk_bf16(v2, v3);
                *(u32x2*)(MX + d0) = wv;
            }
    }
}

struct ChunkRegs { u32x4 ih[2]; float g[16]; };
DI void chunk_load(const P& p, int ch, ChunkRegs& r) {
    const int tid = otid(), d = tid & 127, seg = tid >> 7;
    const int bh = ch >> 5, c = ch & 31, b = bh >> 2, hh = bh & 3;
    const size_t row0 = (size_t)b * 2048 + 64 * c;
    const u16* IH = (const u16*)(p.ws + OFF_IH) + row0 * 512 + hh * 128;
#pragma unroll
    for (int i = 0; i < 2; ++i) { const int cc = tid + 512 * i; r.ih[i] = *(const u32x4*)(IH + (size_t)(cc >> 4) * 512 + (cc & 15) * 8); }
    const float* gp = (const float*)(p.ws + OFF_G) + (row0 + 16 * seg) * 512 + hh * 128 + d;
#pragma unroll
    for (int i = 0; i < 16; ++i) r.g[i] = gp[(size_t)i * 512];
}
DI void chunk_cumsum(const float (&gv)[16], float (&bc)[16], LAS float* segsum, int d, int seg, float& off, float& tot) {
    float run = 0.f;
#pragma unroll
    for (int i = 0; i < 16; ++i) { run += gv[i]; bc[i] = run; }
    segsum[seg * 128 + d] = run;
    __syncthreads();
    off = 0.f; tot = 0.f;
#pragma unroll
    for (int s4 = 0; s4 < 4; ++s4) { const float x = segsum[s4 * 128 + d]; tot += x; off += (s4 < seg) ? x : 0.f; }
}

DI void hgrn_local(const P& p, int ch, const ChunkRegs& r, LAS unsigned char* L) {
    const int tid = otid(), wid = tid >> 6, lane = tid & 63;
    LAS float* segsum = (LAS float*)L;
    LAS unsigned char* KT = L + 2048;
    LAS unsigned char* II = L + 2048 + 18432;
    LAS unsigned char* OUTS = L + 2048 + 18432 + 17408;
    const int d = tid & 127, seg = tid >> 7;
    float bc[16], off, tot;
#pragma unroll
    for (int i = 0; i < 2; ++i) { const int cc = tid + 512 * i; *(LAS u32x4*)(II + (cc >> 4) * 272 + (cc & 15) * 16) = r.ih[i]; }
    chunk_cumsum(r.g, bc, segsum, d, seg, off, tot);
    {
        float kx[16];
#pragma unroll
        for (int i = 0; i < 16; ++i) kx[i] = (1.f - __expf(r.g[i])) * __expf(tot - (off + bc[i]));
        *(LAS bf16x8*)(KT + d * 144 + seg * 32) = pack8(kx);
        *(LAS bf16x8*)(KT + d * 144 + seg * 32 + 16) = pack8(kx + 8);
        if (seg == 0) ((float*)(p.ws + OFF_BLAST))[(size_t)ch * 128 + d] = tot;
    }
    __syncthreads();
    {
        const int col = lane & 31, h = lane >> 5, gi = (lane >> 4) & 1, i16 = lane & 15, tq = i16 >> 2, tp = i16 & 3;
        const int vt = wid >> 1, dt0 = 2 * (wid & 1);
        f32x16 a0, a1;
#pragma unroll
        for (int i = 0; i < 16; ++i) { a0[i] = 0.f; a1[i] = 0.f; }
#pragma unroll
        for (int ks = 0; ks < 4; ++ks) {
            LAS unsigned char* lo = II + (16 * ks + 8 * h + tq) * 272 + (32 * vt + 16 * gi + 4 * tp) * 2;
            const bf16x8 A = tr2(lo, lo + 4 * 272);
            const bf16x8 B0 = *(const LAS bf16x8*)(KT + (32 * dt0 + col) * 144 + (16 * ks + 8 * h) * 2);
            const bf16x8 B1 = *(const LAS bf16x8*)(KT + (32 * (dt0 + 1) + col) * 144 + (16 * ks + 8 * h) * 2);
            a0 = MFMA32(A, B0, a0); a1 = MFMA32(A, B1, a1);
        }
#pragma unroll
        for (int i = 0; i < 16; ++i) {
            const int v = 32 * vt + crow(i, h);
            *(LAS u16*)(OUTS + v * 272 + (32 * dt0 + col) * 2) = bf1(a0[i]);
            *(LAS u16*)(OUTS + v * 272 + (32 * (dt0 + 1) + col) * 2) = bf1(a1[i]);
        }
    }
    __syncthreads();
    {
        u16* SL = (u16*)(p.ws + OFF_SLOC) + (size_t)ch * 16384;
#pragma unroll
        for (int i = 0; i < 4; ++i) { const int cc = tid + 512 * i; const int rr = cc >> 4, c16 = cc & 15; *(u32x4*)(SL + rr * 128 + c16 * 8) = *(const LAS u32x4*)(OUTS + rr * 272 + c16 * 16); }
    }
}

DI void hgrn_scan(const P& p, int first_block) {
    const int nthreads = ((int)gridDim.x - first_block) * 512, t0 = ((int)blockIdx.x - first_block) * 512 + otid();
    for (int gidx = t0; gidx < 65536; gidx += nthreads) {
        const int dg = gidx & 15, v = (gidx >> 4) & 127, bh = gidx >> 11;
        float S[8];
#pragma unroll
        for (int j = 0; j < 8; ++j) S[j] = 0.f;
        u16* base = (u16*)(p.ws + OFF_SLOC) + ((size_t)bh * 32 * 128 + v) * 128 + dg * 8;
        const float* bl = (const float*)(p.ws + OFF_BLAST) + (size_t)bh * 32 * 128 + dg * 8;
#pragma unroll 8
        for (int c = 0; c < 32; ++c) {
            const u32x4 raw = *(const u32x4*)(base + (size_t)c * 16384);
            const f32x4 d0 = *(const f32x4*)(bl + c * 128), d1 = *(const f32x4*)(bl + c * 128 + 4);
            u32x4 o; o[0] = pk_bf16(S[0], S[1]); o[1] = pk_bf16(S[2], S[3]); o[2] = pk_bf16(S[4], S[5]); o[3] = pk_bf16(S[6], S[7]);
            *(u32x4*)(base + (size_t)c * 16384) = o;
#pragma unroll
            for (int j = 0; j < 4; ++j) {
                S[2 * j] = S[2 * j] * __expf(j < 2 ? d0[2 * j] : d1[2 * j - 4]) + bflo(raw[j]);
                S[2 * j + 1] = S[2 * j + 1] * __expf(j < 2 ? d0[2 * j + 1] : d1[2 * j - 3]) + bfhi(raw[j]);
            }
        }
        float* os = p.out + O_SP + ((size_t)bh * 128 + dg * 8) * 128 + v;
#pragma unroll
        for (int j = 0; j < 8; ++j) os[(size_t)j * 128] = S[j];
    }
}

struct OutRegs { ChunkRegs c; u16 q[16]; };
DI void out_load(const P& p, int ch, OutRegs& r) {
    chunk_load(p, ch, r.c);
    const int tid = otid(), d = tid & 127, seg = tid >> 7;
    const int bh = ch >> 5, c = ch & 31, b = bh >> 2, hh = bh & 3;
    const u16* QH = (const u16*)(p.ws + OFF_QH) + ((size_t)b * 2048 + 64 * c + 16 * seg) * 512 + hh * 128 + d;
#pragma unroll
    for (int i = 0; i < 16; ++i) r.q[i] = QH[(size_t)i * 512];
}
DI void hgrn_out(const P& p, int ch, const OutRegs& r, LAS unsigned char* L) {
    const int tid = otid(), wid = tid >> 6, lane = tid & 63;
    const int bh = ch >> 5, c = ch & 31, b = bh >> 2, hh = bh & 3;
    const size_t row0 = (size_t)b * 2048 + 64 * c;
    LAS float* segsum = (LAS float*)L;
    LAS unsigned char* QE = L + 2048;
    LAS unsigned char* KE = L + 2048 + 17408;
    LAS unsigned char* II = L + 2048 + 2 * 17408;
    LAS float* ssq = (LAS float*)(L + 2048 + 3 * 17408);
    const int d = tid & 127, seg = tid >> 7;
    const int col = lane & 31, h = lane >> 5, gi = (lane >> 4) & 1, i16 = lane & 15, tq = i16 >> 2, tp = i16 & 3;
    const int vi = wid & 3, ti = wid >> 2;
    bf16x8 sa[8]; u32x2 gh[4];
    {
        const u16* S0 = (const u16*)(p.ws + OFF_SLOC) + (size_t)ch * 16384 + (size_t)(32 * vi + col) * 128 + 8 * h;
#pragma unroll
        for (int kd = 0; kd < 8; ++kd) sa[kd] = *(const bf16x8*)(S0 + 16 * kd);
        const u16* GH = (const u16*)(p.ws + OFF_GH) + (row0 + 32 * ti + col) * 512 + hh * 128 + 32 * vi;
#pragma unroll
        for (int g4 = 0; g4 < 4; ++g4) gh[g4] = *(const u32x2*)(GH + 8 * g4 + 4 * h);
    }
    float bc[16], off, tot;
#pragma unroll
    for (int i = 0; i < 2; ++i) { const int cc = tid + 512 * i; *(LAS u32x4*)(II + (cc >> 4) * 272 + (cc & 15) * 16) = r.c.ih[i]; }
    chunk_cumsum(r.c.g, bc, segsum, d, seg, off, tot);
#pragma unroll
    for (int i = 0; i < 16; ++i) {
        const float bb = off + bc[i];
        const int s = 16 * seg + i;
        *(LAS u16*)(QE + s * 272 + d * 2) = bf1(bf2f(r.q[i]) * __expf(bb));
        *(LAS u16*)(KE + s * 272 + d * 2) = bf1((1.f - __expf(r.c.g[i])) * __expf(fminf(-bb, 80.f)));
    }
    __syncthreads();
    bf16x8 qf[8];
#pragma unroll
    for (int kd = 0; kd < 8; ++kd) qf[kd] = *(const LAS bf16x8*)(QE + (32 * ti + col) * 272 + (16 * kd + 8 * h) * 2);
    f32x16 o;
#pragma unroll
    for (int i = 0; i < 16; ++i) o[i] = 0.f;
#pragma unroll
    for (int kd = 0; kd < 8; ++kd) o = MFMA32(sa[kd], qf[kd], o);
#pragma unroll
    for (int si = 0; si < 2; ++si) {
        if (si <= ti) {
            f32x16 pt;
#pragma unroll
            for (int i = 0; i < 16; ++i) pt[i] = 0.f;
#pragma unroll
            for (int kd = 0; kd < 8; ++kd) { const bf16x8 ka = *(const LAS bf16x8*)(KE + (32 * si + col) * 272 + (16 * kd + 8 * h) * 2); pt = MFMA32(ka, qf[kd], pt); }
            float w[16];
#pragma unroll
            for (int i = 0; i < 16; ++i) w[i] = (si < ti || crow(i, h) <= col) ? pt[i] : 0.f;
            const bf16x8 pw0 = pack8(w), pw1 = pack8(w + 8);
#pragma unroll
            for (int s2 = 0; s2 < 2; ++s2) {
                LAS unsigned char* lo = II + (32 * si + 16 * s2 + 4 * h + tq) * 272 + (32 * vi + 16 * gi + 4 * tp) * 2;
                const bf16x8 A = tr2(lo, lo + 8 * 272);
                o = MFMA32(A, s2 ? pw1 : pw0, o);
            }
        }
    }
    {
        float ss = 0.f;
#pragma unroll
        for (int i = 0; i < 16; ++i) ss += o[i] * o[i];
        ss += __shfl_xor(ss, 32);
        if (h == 0) ssq[(32 * ti + col) * 4 + vi] = ss;
    }
    __syncthreads();
    {
        const int t = 32 * ti + col;
        const float tot2 = (ssq[t * 4] + ssq[t * 4 + 1]) + (ssq[t * 4 + 2] + ssq[t * 4 + 3]);
        const float rs = rsqrtf(tot2 * (1.f / 128.f) + 1e-6f);
        u16* MX = (u16*)(p.ws + OFF_XB) + (row0 + t) * 1024 + 512 + hh * 128 + 32 * vi;
#pragma unroll
        for (int g4 = 0; g4 < 4; ++g4) {
            u32x2 wv; wv[0] = pk_bf16(o[4 * g4] * rs * bflo(gh[g4][0]), o[4 * g4 + 1] * rs * bfhi(gh[g4][0])); wv[1] = pk_bf16(o[4 * g4 + 2] * rs * bflo(gh[g4][1]), o[4 * g4 + 3] * rs * bfhi(gh[g4][1]));
            *(u32x2*)(MX + 8 * g4 + 4 * h) = wv;
        }
    }
}

DI void sample_hgrn(const P& p, int bh, unsigned char* shm) {
    const int tid = otid(), b = bh >> 2, hh = bh & 3;
    float* F = (float*)shm; float* Q = F + 2048; float* I = Q + 2048; float* PART = I + 2048; float* O = PART + 512;
    for (int e = tid; e < 2048; e += 512) {
        const int t = e >> 7, c = e & 127; const size_t off = (size_t)(NP + b * 16 + t) * 512 + hh * 128 + c;
        F[e] = __expf(((const float*)(p.ws + OFF_G))[off]); Q[e] = bf2f(((const u16*)(p.ws + OFF_QH))[off]); I[e] = bf2f(((const u16*)(p.ws + OFF_IH))[off]);
    }
    const int v = tid & 127, dq = tid >> 7;
    float S[32];
#pragma unroll
    for (int dd = 0; dd < 32; ++dd) S[dd] = p.state_s[((size_t)bh * 128 + 32 * dq + dd) * 128 + v];
    __syncthreads();
    for (int t = 0; t < 16; ++t) {
        const float iv = I[t * 128 + v]; float po = 0.f;
#pragma unroll
        for (int dd = 0; dd < 32; ++dd) { const float f = F[t * 128 + 32 * dq + dd], q = Q[t * 128 + 32 * dq + dd]; S[dd] = f * S[dd] + (1.f - f) * iv; po += S[dd] * q; }
        PART[dq * 128 + v] = po;
        __syncthreads();
        if (dq == 0) O[t * 128 + v] = (PART[v] + PART[128 + v]) + (PART[256 + v] + PART[384 + v]);
        __syncthreads();
    }
#pragma unroll
    for (int dd = 0; dd < 32; ++dd) p.out[O_SS + ((size_t)bh * 128 + 32 * dq + dd) * 128 + v] = S[dd];
    {
        const int t = tid >> 5, l32 = tid & 31;
        const float4 o = *(const float4*)(O + t * 128 + l32 * 4);
        float ss = (o.x * o.x + o.y * o.y) + (o.z * o.z + o.w * o.w);
        ss += __shfl_xor(ss, 16); ss += __shfl_xor(ss, 8); ss += __shfl_xor(ss, 4); ss += __shfl_xor(ss, 2); ss += __shfl_xor(ss, 1);
        const float rs = rsqrtf(ss * (1.f / 128.f) + 1e-6f);
        const size_t row = (size_t)NP + b * 16 + t;
        const u32x2 gh = *(const u32x2*)((const u16*)(p.ws + OFF_GH) + row * 512 + hh * 128 + l32 * 4);
        u32x2 wv; wv[0] = pk_bf16(o.x * rs * bflo(gh[0]), o.y * rs * bfhi(gh[0])); wv[1] = pk_bf16(o.z * rs * bflo(gh[1]), o.w * rs * bfhi(gh[1]));
        *(u32x2*)((u16*)(p.ws + OFF_XB) + row * 1024 + 512 + hh * 128 + l32 * 4) = wv;
    }
}

DI void sample_out_proj(const P& p, int cb) {
    const int tid_ = otid(); const int lane = tid_ & 63, wid = tid_ >> 6, fr = lane & 15, fq = lane >> 4;
    const int r = 16 * wid + fr;
    const f32x4 acc = slice16((const u16*)(p.ws + OFF_XB) + (size_t)(NP + r) * 1024 + 8 * fq, (const u16*)(p.ws + OFF_WOUTT) + (size_t)(16 * cb + fr) * 1024 + 8 * fq);
    *(f32x4*)((float*)(p.ws + OFF_PRE) + (size_t)r * 1024 + 16 * cb + 4 * fq) = acc;
}
DI void sample_ln(const P& p, int r, int lane) {
    const float* xr = p.x_sample + (size_t)r * 1024; const float* pr = (const float*)(p.ws + OFF_PRE) + (size_t)r * 1024;
    f32x4 v[4]; float s = 0.f;
#pragma unroll
    for (int i = 0; i < 4; ++i) { v[i] = *(const f32x4*)(xr + 256 * i + 4 * lane) * ALPHA + *(const f32x4*)(pr + 256 * i + 4 * lane); s += (v[i][0] + v[i][1]) + (v[i][2] + v[i][3]); }
#pragma unroll
    for (int o = 32; o >= 1; o >>= 1) s += __shfl_xor(s, o);
    const float mean = s * (1.f / 1024.f); float q = 0.f;
#pragma unroll
    for (int i = 0; i < 4; ++i) { const f32x4 dd = v[i] - mean; q += (dd[0] * dd[0] + dd[1] * dd[1]) + (dd[2] * dd[2] + dd[3] * dd[3]); }
#pragma unroll
    for (int o = 32; o >= 1; o >>= 1) q += __shfl_xor(q, o);
    const float rstd = rsqrtf(q * (1.f / 1024.f) + 1e-5f);
    float* yr = p.out + O_YS + (size_t)r * 1024;
#pragma unroll
    for (int i = 0; i < 4; ++i) *(f32x4*)(yr + 256 * i + 4 * lane) = (v[i] - mean) * rstd * *(const f32x4*)(p.ln_g + 256 * i + 4 * lane) + *(const f32x4*)(p.ln_b + 256 * i + 4 * lane);
}

__global__ void __launch_bounds__(512, 2) mega(P p) {
    extern __shared__ __attribute__((aligned(16))) unsigned char shm[];
    LAS unsigned char* L = (LAS unsigned char*)shm;
    cg::grid_group grid = cg::this_grid();
    const int G = (int)gridDim.x, bid = (int)blockIdx.x;
    const bool multi = (p.ph_hi - p.ph_lo) > 1;
#define PH_ON(n) (p.ph_lo <= (n) && (n) < p.ph_hi && (PHMASK & (1 << (n))))
#define PH_SYNC(n) do { if (multi && p.ph_lo <= (n) && (n) + 1 < p.ph_hi) grid.sync(); } while (0)
    REPS(0) { if (PH_ON(0)) phase0(p, shm); if (REP_PH == 0 && rep_ == 0) grid.sync(); }
    PH_SYNC(0);
    REPS(1) { if (REP_PH == 1 && rep_ == 1) grid.sync();
    if (PH_ON(1)) {
        pg8::StaticOrder S; S.init(NP, 4096, G, bid);
        pg8::Gemm g; g.A = (const u16*)(p.ws + OFF_XB); g.Bt = (const u16*)(p.ws + OFF_WINT); g.M = NP; g.N = 4096; g.K = 1024;
        EpiProj E; E.p = p;
        pg8::gemm_phase<EpiProj, pg8::StaticOrder>(L, g, S, E);
        sample_proj(p);
    } }
    PH_SYNC(1);
    REPS(2) { if (REP_PH == 2 && rep_ == 1) grid.sync();
    if (PH_ON(2)) {
        const int t2_ = otid(), wid2 = t2_ >> 6, lane2 = t2_ & 63;
        for (int it = bid; it < 552; it += G) {
            __syncthreads();
            if (it < 32) sample_hgrn(p, it, shm);
            else if (it < 40) attn_wave<true>(p, (it - 32) * 8 + wid2, L + wid2 * 4608, lane2);
            else attn_wave<false>(p, (it - 40) * 8 + wid2, L + wid2 * 4608, lane2);
        }
        ChunkRegs cur;
        if (bid < 1024) chunk_load(p, bid, cur);
        for (int ch = bid; ch < 1024; ch += G) {
            ChunkRegs nxt;
            const bool hn = ch + G < 1024;
            if (hn) chunk_load(p, ch + G, nxt);
            __syncthreads();
            hgrn_local(p, ch, cur, L);
            if (hn) cur = nxt;
        }
    } }
    PH_SYNC(2);
    if (PH_ON(3)) {
        if (bid < 64) sample_out_proj(p, bid);
        else hgrn_scan(p, 64);
    }
    PH_SYNC(3);
    REPS(4) { if (REP_PH == 4 && rep_ == 1) grid.sync();
    if (PH_ON(4)) {
        OutRegs cur;
        if (bid < 1024) out_load(p, bid, cur);
        for (int ch = bid; ch < 1024; ch += G) {
            OutRegs nxt;
            const bool hn = ch + G < 1024;
            if (hn) out_load(p, ch + G, nxt);
            __syncthreads();
            hgrn_out(p, ch, cur, L);
            if (hn) cur = nxt;
        }
    } }
    PH_SYNC(4);
    REPS(5) { if (REP_PH == 5 && rep_ == 1) grid.sync();
    if (PH_ON(5)) {
        if (bid < 16) { const int t_ = otid(); sample_ln(p, bid * 8 + (t_ >> 6), t_ & 63); }
        pg8::SingleUnit S; S.pm = bid & 63; S.pn = bid >> 6;
        pg8::Gemm g; g.A = (const u16*)(p.ws + OFF_XB); g.Bt = (const u16*)(p.ws + OFF_WOUTT); g.M = NP; g.N = 1024; g.K = 1024;
        EpiLN E; E.p = p;
        pg8::gemm_phase<EpiLN, pg8::SingleUnit>(L, g, S, E);
    } }
}

extern "C" void kernel_launch(void* const* d_in, const int* in_sizes, int n_in, void* d_out, int out_size, void* d_ws, size_t ws_size, hipStream_t stream) {
    static int grid = 0;
    if (grid == 0) {
        int dev = 0, cus = 0, per_cu = 0;
        (void)hipGetDevice(&dev);
        (void)hipDeviceGetAttribute(&cus, hipDeviceAttributeMultiprocessorCount, dev);
        (void)hipFuncSetAttribute((const void*)mega, hipFuncAttributeMaxDynamicSharedMemorySize, LDS_BYTES);
        (void)hipOccupancyMaxActiveBlocksPerMultiprocessor(&per_cu, (const void*)mega, 512, LDS_BYTES);
        grid = cus * per_cu;
        if (grid > 256) grid = 256;
        if (grid != 256 || ws_size < WS_END) { fprintf(stderr, "kernel_launch: needs 256 co-resident workgroups (got %d x %d) and %zu B of workspace (got %zu)\n", cus, per_cu, (size_t)WS_END, ws_size); }
    }
    (void)hipMemsetAsync((unsigned char*)d_ws + OFF_CTR, 0, SZ_CTR, stream);
    P p{};
    p.x_prompt = (const float*)d_in[0]; p.x_sample = (const float*)d_in[1]; p.cache_k = (const float*)d_in[2]; p.cache_v = (const float*)d_in[3];
    p.state_s = (const float*)d_in[4]; p.w_in = (const float*)d_in[5]; p.w_out = (const float*)d_in[6]; p.lb_logits = (const float*)d_in[7];
    p.norm_g = (const float*)d_in[8]; p.ln_g = (const float*)d_in[9]; p.ln_b = (const float*)d_in[10];
    p.out = (float*)d_out; p.ws = (unsigned char*)d_ws; p.ph_lo = 0; p.ph_hi = 6;
    void* args[] = {&p};
    hipError_t e = hipLaunchCooperativeKernel((const void*)mega, dim3(grid), dim3(512), args, LDS_BYTES, stream);
    if (e != hipSuccess) fprintf(stderr, "cooperative launch failed: %s (grid %d)\n", hipGetErrorString(e), grid);
}
```

```cpp
#include <hip/hip_runtime.h>
#include <hip/hip_cooperative_groups.h>
#include <cstdio>
namespace cg = cooperative_groups;

#define DI __device__ __forceinline__
#define LAS __attribute__((address_space(3)))
typedef unsigned short u16;
typedef short bf16x8 __attribute__((ext_vector_type(8)));
typedef short s16x4 __attribute__((ext_vector_type(4)));
typedef float f32x4 __attribute__((ext_vector_type(4)));
typedef float f32x2 __attribute__((ext_vector_type(2)));
typedef float f32x16 __attribute__((ext_vector_type(16)));
typedef unsigned u32x4 __attribute__((ext_vector_type(4)));
typedef unsigned u32x2 __attribute__((ext_vector_type(2)));
typedef __bf16 bf16x2_t __attribute__((ext_vector_type(2)));

constexpr int NP = 16384;
constexpr int NTOK = 16512;
constexpr int MPAD = 16640;
constexpr float ALPHA = 1.189207115002721f;
constexpr float QSCALE = 0.18033688011112042f;

constexpr size_t O_YP = 0, O_YS = 16777216, O_KP = 16908288, O_VP = 25296896, O_SP = 33685504, O_KS = 34209792, O_VS = 34275328, O_SS = 34340864;

constexpr size_t SZ_XB = (size_t)MPAD * 1024 * 2;
constexpr size_t SZ_H = (size_t)MPAD * 512 * 2;
constexpr size_t OFF_XB = 0;
constexpr size_t OFF_WINT = OFF_XB + SZ_XB;
constexpr size_t OFF_WOUTT = OFF_WINT + (size_t)4096 * 1024 * 2;
constexpr size_t OFF_QA = OFF_WOUTT + (size_t)1024 * 1024 * 2;
constexpr size_t OFF_KA = OFF_QA + SZ_H;
constexpr size_t OFF_VA = OFF_KA + SZ_H;
constexpr size_t OFF_GA = OFF_VA + SZ_H;
constexpr size_t OFF_QH = OFF_GA + SZ_H;
constexpr size_t OFF_IH = OFF_QH + SZ_H;
constexpr size_t OFF_GH = OFF_IH + SZ_H;
constexpr size_t OFF_G = OFF_GH + SZ_H;
constexpr size_t OFF_SLOC = OFF_G + (size_t)MPAD * 512 * 4;
constexpr size_t OFF_BLAST = OFF_SLOC + (size_t)1024 * 16384 * 2;
constexpr size_t OFF_STATS = OFF_BLAST + (size_t)1024 * 128 * 4;
constexpr size_t OFF_CTR = OFF_STATS + (size_t)65 * 4 * 256 * 2 * 4;
constexpr size_t SZ_CTR = 65 * 64 * 4;
constexpr size_t OFF_BAR = OFF_CTR + 16896;
constexpr size_t SZ_ZERO = 16896 + 14080;
constexpr size_t OFF_PRE = OFF_BAR + 14080;
constexpr size_t WS_END = OFF_PRE + (size_t)128 * 1024 * 4;
constexpr int LDS_BYTES = 131072 + 16;
#ifndef PHMASK
#define PHMASK 63
#endif
#ifndef REP_PH
#define REP_PH -1
#endif
#ifndef TIMER_PH
#define TIMER_PH -1
#endif
#ifndef TIMER_PRE
#define TIMER_PRE 0
#endif
#define REPS(n) for (int rep_ = 0; rep_ < ((n) == REP_PH ? 2 : 1); ++rep_)

struct P {
    const float *x_prompt, *x_sample, *cache_k, *cache_v, *state_s, *w_in, *w_out, *lb_logits, *norm_g, *ln_g, *ln_b;
    float* out;
    unsigned char* ws;
    int ph_lo, ph_hi;
};

DI unsigned pk_bf16(float lo, float hi) { f32x2 v = {lo, hi}; bf16x2_t b = __builtin_convertvector(v, bf16x2_t); return __builtin_bit_cast(unsigned, b); }
DI u16 bf1(float x) { return (u16)(pk_bf16(x, 0.f) & 0xffffu); }
DI float bf2f(u16 v) { return __uint_as_float(((unsigned)v) << 16); }
DI float bflo(unsigned v) { return __uint_as_float(v << 16); }
DI float bfhi(unsigned v) { return __uint_as_float(v & 0xffff0000u); }
DI float ex2(float x) { return __builtin_amdgcn_exp2f(x); }
DI float lg2(float x) { return __builtin_amdgcn_logf(x); }
DI float sigm(float x) { return __builtin_amdgcn_rcpf(1.f + ex2(-1.4426950408889634f * x)); }
DI float silu(float x) { return x * __builtin_amdgcn_rcpf(1.f + ex2(-1.4426950408889634f * x)); }
DI float fexp(float x) { return ex2(1.4426950408889634f * x); }
DI float flog(float x) { return 0.6931471805599453f * lg2(x); }
DI int otid() { int t = threadIdx.x; asm volatile("" : "+v"(t)); return t; }
DI void lds_barrier() { asm volatile("s_waitcnt lgkmcnt(0)" ::: "memory"); __builtin_amdgcn_s_barrier(); asm volatile("" ::: "memory"); }
DI float xor32(float x, int h) { const auto r = __builtin_amdgcn_permlane32_swap(__float_as_uint(x), __float_as_uint(x), false, false); return __uint_as_float(h ? r[0] : r[1]); }
DI int crow(int i, int h) { return (i & 3) + 8 * (i >> 2) + 4 * h; }
DI bf16x8 pack8(const float* w) { u32x4 r; r[0] = pk_bf16(w[0], w[1]); r[1] = pk_bf16(w[2], w[3]); r[2] = pk_bf16(w[4], w[5]); r[3] = pk_bf16(w[6], w[7]); return __builtin_bit_cast(bf16x8, r); }
DI bf16x8 pack8v(float4 a, float4 b) { u32x4 r; r[0] = pk_bf16(a.x, a.y); r[1] = pk_bf16(a.z, a.w); r[2] = pk_bf16(b.x, b.y); r[3] = pk_bf16(b.z, b.w); return __builtin_bit_cast(bf16x8, r); }
DI bf16x8 tr2(LAS unsigned char* lo, LAS unsigned char* hi) {
    s16x4 a = __builtin_amdgcn_ds_read_tr16_b64_v4i16((LAS s16x4*)lo);
    s16x4 b = __builtin_amdgcn_ds_read_tr16_b64_v4i16((LAS s16x4*)hi);
    return __builtin_shufflevector(a, b, 0, 1, 2, 3, 4, 5, 6, 7);
}
#define MFMA32(a, b, c) __builtin_amdgcn_mfma_f32_32x32x16_bf16((a), (b), (c), 0, 0, 0)


#define XB_TMO      128
#define XB_XCNT(j)  (256  + 64 * (j))
#define XB_XSUB(j)  (1280 + 64 * (j))
#define XB_XGEN(j)  (2304 + 64 * (j))
#define XB_TOP      3328
#define XB_TOPGEN   3392
#define XCD_BAR_WORDS 3456
#define XB_SPIN_CAP (1u << 18)
DI unsigned xb_ld(unsigned* p)              { return __hip_atomic_load(p, __ATOMIC_RELAXED, __HIP_MEMORY_SCOPE_AGENT); }
DI unsigned xb_add(unsigned* p, unsigned v) { return __hip_atomic_fetch_add(p, v, __ATOMIC_RELAXED, __HIP_MEMORY_SCOPE_AGENT); }
DI unsigned xb_xcc_id() { return (unsigned)__builtin_amdgcn_s_getreg((3 << 11) | 20) & 0xFu; }
#define XB_SPIN(cond, bar) do { unsigned _sp = 0; while (cond) { __builtin_amdgcn_s_sleep(1); \
    if ((++_sp & 255u) == 0u) { if (xb_ld(&(bar)[XB_TMO])) break; if (_sp > XB_SPIN_CAP) { atomicAdd(&(bar)[XB_TMO], 1u); break; } } } } while (0)
struct XcdBarrier { unsigned* bar; unsigned x; volatile LAS unsigned* st; };
DI XcdBarrier xcd_barrier_post(unsigned* bar, volatile LAS unsigned* st) {
    XcdBarrier b; b.bar = bar; b.x = xb_xcc_id(); b.st = st;
    if (threadIdx.x == 0) (void)xb_add(&bar[XB_XCNT(b.x)], 1u);
    return b;
}
DI void xcd_barrier_complete(unsigned* bar, unsigned x, unsigned& nloc, unsigned& nx) {
    const unsigned G = gridDim.x * gridDim.y * gridDim.z;
    unsigned sum, cnt, mine, sp = 0u;
    for (;;) {
        sum = 0u; cnt = 0u; mine = 0u;
#pragma unroll
        for (unsigned j = 0; j < 16; ++j) { const unsigned c = xb_ld(&bar[XB_XCNT(j)]); sum += c; cnt += (c > 0u) ? 1u : 0u; mine = (j == x) ? c : mine; }
        if (sum == G) break;
        __builtin_amdgcn_s_sleep(1);
        if ((++sp & 255u) == 0u) { if (xb_ld(&bar[XB_TMO])) break; if (sp > XB_SPIN_CAP) { atomicAdd(&bar[XB_TMO], 1u); break; } }
    }
    nloc = mine > 0u ? mine : 1u; nx = cnt > 0u ? cnt : 1u;
}
DI void xcd_barrier(const XcdBarrier& b) {
    asm volatile("s_waitcnt vmcnt(0)" ::: "memory");
    __syncthreads();
    if (threadIdx.x == 0) {
        unsigned* bar = b.bar;
        __builtin_amdgcn_s_waitcnt(0);
        unsigned nloc = b.st[0], nx = b.st[1];
        if (nloc == 0u) { xcd_barrier_complete(bar, b.x, nloc, nx); b.st[0] = nloc; b.st[1] = nx; }
        const unsigned old = xb_add(&bar[XB_XSUB(b.x)], 1u);
        const unsigned gen = old / nloc;
        if (old + 1u == (gen + 1u) * nloc) {
            __builtin_amdgcn_fence(__ATOMIC_RELEASE, "agent");
            asm volatile("s_waitcnt vmcnt(0)" ::: "memory");
            const unsigned og = xb_add(&bar[XB_TOP], 1u);
            const unsigned tg = og / nx;
            if (og + 1u == (tg + 1u) * nx) xb_add(&bar[XB_TOPGEN], 1u);
            else XB_SPIN(xb_ld(&bar[XB_TOPGEN]) == tg, bar);
            __builtin_amdgcn_fence(__ATOMIC_ACQUIRE, "agent");
            xb_add(&bar[XB_XGEN(b.x)], 1u);
            asm volatile("s_waitcnt vmcnt(0)" ::: "memory");
        } else {
            XB_SPIN(xb_ld(&bar[XB_XGEN(b.x)]) == gen, bar);
            __builtin_amdgcn_fence(__ATOMIC_ACQUIRE, "agent");
            asm volatile("s_waitcnt vmcnt(0)" ::: "memory");
        }
    }
    __syncthreads();
}

namespace pg8 {
constexpr int BM = 256, BK = 64, HALF = 128, HTB = HALF * BK * 2, STAGE_BYTES = 8 * HTB, NXCD = 8, WGM = 8;
DI int lds_byte(int r, int c) { const int st = (r >> 4) * 2 + (c >> 5), rr = r & 15, cc = c & 31, ob = rr * 64 + cc * 2; return st * 1024 + (ob ^ (((ob >> 9) & 1) << 5)); }
DI void stage_rc(int b, int& R, int& C) { const int st = b / 1024, sb = b % 1024, swz = sb ^ (((sb >> 9) & 1) << 5); R = (st >> 1) * 16 + swz / 64; C = (st & 1) * 32 + (swz % 64) / 2; }
struct Unit { int pm, pn; };
struct Gemm { const u16* A; const u16* Bt; int M, N, K; };
struct StaticOrder {
    int nM, nN, nwg, G, c;
    DI void init(int M, int N, int G_, int c_) { nM = M / BM; nN = N / BM; nwg = nM * nN; G = G_; c = c_; }
    DI bool next(int i, Unit& u) const {
        const long L = (long)i * G + c; if (L >= nwg) return false;
        int wgid = (int)L; { const int q = nwg / NXCD, r = nwg % NXCD, xcd = wgid % NXCD, off = wgid / NXCD; wgid = (xcd < r ? xcd * (q + 1) : r * (q + 1) + (xcd - r) * q) + off; }
        const int nig = WGM * nN, gid = wgid / nig, fm = gid * WGM, gsz = (nM - fm) < WGM ? (nM - fm) : WGM;
        u.pm = fm + ((wgid % nig) % gsz); u.pn = (wgid % nig) / gsz;
        if (nN == 16 && ((u.pn >> 2) == 1 || (u.pn >> 2) == 2)) u.pn ^= 2;
        return true;
    }
};
struct SingleUnit {
    int pm, pn;
    DI bool next(int i, Unit& u) const { if (i) return false; u.pm = pm; u.pn = pn; return true; }
};

template <class Epi, class Sched>
DI void gemm_phase(LAS unsigned char* lds, const Gemm g, const Sched& S, const Epi& E) {
    const int tid = otid(), wid = __builtin_amdgcn_readfirstlane(tid >> 6), lane = tid & 63, wr = wid >> 2, wc = wid & 3, fr = lane & 15, fq = lane >> 4;
    const int K = g.K, nt = K / BK;
    unsigned voffA[2], voffB[2];
#pragma unroll
    for (int i = 0; i < 2; ++i) { int R, C; stage_rc(tid * 16 + i * 8192, R, C); const int rho = R & 31; const int Rb = Epi::PERM ? ((R & ~31) + 8 * ((rho & 15) >> 2) + 4 * (rho >> 4) + (rho & 3)) : R;
        voffA[i] = (unsigned)(R * K + C) * 2u; voffB[i] = (unsigned)(Rb * K + C) * 2u; }
    const size_t kstep = (size_t)(BK * 2);
    const size_t hstep = (size_t)HALF * K * 2;
    const size_t tstep = 2 * hstep;
    const unsigned ldsw = (unsigned)wid * 1024u;
    const int aoff = lds_byte(wr * 64 + fr, fq * 8), boff = lds_byte(wc * 32 + fr, fq * 8);
#define PG8_SA(b, h) (((b) * 2 + (h)) * HTB)
#define PG8_SB(b, h) ((4 + (b) * 2 + (h)) * HTB)
#define PG8_STAGE(bufoff, gbase, voff) do { _Pragma("unroll") for (int _i = 0; _i < 2; ++_i) \
        __builtin_amdgcn_global_load_lds((const unsigned*)((const char*)(gbase) + (voff)[_i]), (LAS unsigned*)(lds + (bufoff) + ldsw + _i * 8192), 16, 0, 0); } while (0)
#define PG8_LDA(dst, b, h) do { _Pragma("unroll") for (int m = 0; m < 4; ++m) _Pragma("unroll") for (int k = 0; k < 2; ++k) dst[m][k] = *(const LAS bf16x8*)(lds + PG8_SA(b, h) + aoff + m * 2048 + k * 1024); } while (0)
#define PG8_LDB(dst, b, h) do { _Pragma("unroll") for (int n = 0; n < 2; ++n) _Pragma("unroll") for (int k = 0; k < 2; ++k) dst[n][k] = *(const LAS bf16x8*)(lds + PG8_SB(b, h) + boff + n * 2048 + k * 1024); } while (0)
#define PG8_MMA(ai, bj, At, Bt) do { __builtin_amdgcn_s_setprio(1); _Pragma("unroll") for (int m = 0; m < 4; ++m) _Pragma("unroll") for (int n = 0; n < 2; ++n) _Pragma("unroll") for (int k = 0; k < 2; ++k) \
        acc[ai][bj][m][n] = __builtin_amdgcn_mfma_f32_16x16x32_bf16(Bt[n][k], At[m][k], acc[ai][bj][m][n], 0, 0, 0); __builtin_amdgcn_s_setprio(0); } while (0)
#define PG8_WAIT_V(n) asm volatile("s_waitcnt vmcnt(" #n ")" ::: "memory")
#define PG8_WAIT_L(n) asm volatile("s_waitcnt lgkmcnt(" #n ")" ::: "memory")
#define PG8_BAR __builtin_amdgcn_s_barrier()
#define PG8_SCHED __builtin_amdgcn_sched_barrier(0)
    Unit cur, nxt; int ui = 0;
    if (!S.next(0, cur)) return;
    f32x4 acc[2][2][4][2];
#pragma unroll
    for (int a = 0; a < 2; ++a)
#pragma unroll
        for (int b = 0; b < 2; ++b)
#pragma unroll
            for (int m = 0; m < 4; ++m)
#pragma unroll
                for (int n = 0; n < 2; ++n) acc[a][b][m][n] = (f32x4){0.f, 0.f, 0.f, 0.f};
    bf16x8 At[4][2], B0[2][2], B1[2][2];
    const char* cA = (const char*)g.A + (size_t)cur.pm * tstep; const char* cB = (const char*)g.Bt + (size_t)cur.pn * tstep;
    PG8_STAGE(PG8_SB(0, 0), cB, voffB); PG8_STAGE(PG8_SA(0, 0), cA, voffA); PG8_STAGE(PG8_SB(0, 1), cB + hstep, voffB); PG8_STAGE(PG8_SA(0, 1), cA + hstep, voffA);
    if (wr == 1) PG8_BAR;
    PG8_WAIT_V(4); PG8_BAR;
    PG8_STAGE(PG8_SB(1, 0), cB + kstep, voffB); PG8_STAGE(PG8_SA(1, 0), cA + kstep, voffA); PG8_STAGE(PG8_SB(1, 1), cB + hstep + kstep, voffB);
    PG8_WAIT_V(6); PG8_BAR;
    for (;;) {
        const bool has_next = S.next(ui + 1, nxt);
        const char* nA = has_next ? (const char*)g.A + (size_t)nxt.pm * tstep : cA; const char* nB = has_next ? (const char*)g.Bt + (size_t)nxt.pn * tstep : cB;
        for (int t = 0; t < nt; t += 2) {
            const bool last = (t == nt - 2);
            const char* a1 = cA + (size_t)(t + 1) * kstep;
            const char* a2 = last ? nA : cA + (size_t)(t + 2) * kstep; const char* b2 = last ? nB : cB + (size_t)(t + 2) * kstep;
            const char* a3 = a2 + kstep; const char* b3 = b2 + kstep;
            PG8_LDB(B0, 0, 0); PG8_SCHED; PG8_LDA(At, 0, 0); PG8_STAGE(PG8_SA(1, 1), a1 + hstep, voffA);
            PG8_WAIT_L(8); PG8_BAR; PG8_WAIT_L(0); PG8_MMA(0, 0, At, B0); PG8_BAR; PG8_SCHED;
            PG8_LDB(B1, 0, 1); PG8_STAGE(PG8_SB(0, 0), b2, voffB);
            PG8_BAR; PG8_WAIT_L(0); PG8_MMA(0, 1, At, B1); PG8_BAR;
            PG8_LDA(At, 0, 1); PG8_STAGE(PG8_SA(0, 0), a2, voffA);
            PG8_BAR; PG8_WAIT_L(0); PG8_MMA(1, 0, At, B0); PG8_BAR; PG8_SCHED;
            PG8_STAGE(PG8_SB(0, 1), b2 + hstep, voffB);
            PG8_WAIT_V(6); PG8_BAR; PG8_MMA(1, 1, At, B1); PG8_BAR;
            PG8_LDB(B0, 1, 0); PG8_SCHED; PG8_LDA(At, 1, 0); PG8_STAGE(PG8_SA(0, 1), a2 + hstep, voffA);
            PG8_WAIT_L(8); PG8_BAR; PG8_WAIT_L(0); PG8_MMA(0, 0, At, B0); PG8_BAR; PG8_SCHED;
            PG8_LDB(B1, 1, 1); PG8_STAGE(PG8_SB(1, 0), b3, voffB);
            PG8_BAR; PG8_WAIT_L(0); PG8_MMA(0, 1, At, B1); PG8_BAR;
            PG8_LDA(At, 1, 1); PG8_STAGE(PG8_SA(1, 0), a3, voffA);
            PG8_BAR; PG8_WAIT_L(0); PG8_MMA(1, 0, At, B0); PG8_BAR; PG8_SCHED;
            PG8_STAGE(PG8_SB(1, 1), b3 + hstep, voffB);
            PG8_WAIT_V(6); PG8_BAR; PG8_MMA(1, 1, At, B1); PG8_BAR;
        }
        if constexpr (!Epi::AFTER_DRAIN) { int fr2 = fr, fq2 = fq, wr2 = wr, wc2 = wc; asm volatile("" : "+v"(fr2), "+v"(fq2), "+s"(wr2), "+s"(wc2)); E(acc, cur, wr2, wc2, fr2, fq2); }
        if (!has_next) break;
#pragma unroll
        for (int a = 0; a < 2; ++a)
#pragma unroll
            for (int b = 0; b < 2; ++b)
#pragma unroll
                for (int m = 0; m < 4; ++m)
#pragma unroll
                    for (int n = 0; n < 2; ++n) acc[a][b][m][n] = (f32x4){0.f, 0.f, 0.f, 0.f};
        cur = nxt; cA = nA; cB = nB; ++ui;
    }
    PG8_WAIT_V(0);
    if (wr == 0) PG8_BAR;
    PG8_BAR;
    if constexpr (Epi::AFTER_DRAIN) { int fr2 = fr, fq2 = fq, wr2 = wr, wc2 = wc, tid2 = tid; asm volatile("" : "+v"(fr2), "+v"(fq2), "+s"(wr2), "+s"(wc2), "+v"(tid2)); E.fused(acc, cur, wr2, wc2, fr2, fq2, lds, tid2); }
#undef PG8_SA
#undef PG8_SB
#undef PG8_STAGE
#undef PG8_LDA
#undef PG8_LDB
#undef PG8_MMA
#undef PG8_WAIT_V
#undef PG8_WAIT_L
#undef PG8_BAR
#undef PG8_SCHED
}
}

template <int SEG> DI f32x4 proj_aux(const P& p, int cc) {
    f32x4 a = {0.f, 0.f, 0.f, 0.f};
    if constexpr (SEG == 5) {
        const f32x4 l0 = *(const f32x4*)(p.lb_logits + cc), l1 = *(const f32x4*)(p.lb_logits + 512 + cc);
#pragma unroll
        for (int j = 0; j < 4; ++j) a[j] = sigm(l0[j] - l1[j]);
    }
    if constexpr (SEG == 7) a = *(const f32x4*)(p.norm_g + cc);
    return a;
}
template <int SEG> DI void proj_store(const P& p, int row, int cc, f32x4 v, f32x4 aux) {
    unsigned char* ws = p.ws;
    if constexpr (SEG == 5) {
        f32x4 g;
#pragma unroll
        for (int j = 0; j < 4; ++j) { const float lb = aux[j]; g[j] = flog(lb + (1.f - lb) * sigm(v[j])); }
        typedef _Float16 h16x4 __attribute__((ext_vector_type(4)));
        h16x4 gh4; gh4[0] = (_Float16)g[0]; gh4[1] = (_Float16)g[1]; gh4[2] = (_Float16)g[2]; gh4[3] = (_Float16)g[3];
        *(h16x4*)((_Float16*)(ws + OFF_G) + (size_t)row * 512 + cc) = gh4;
    } else {
        if constexpr (SEG == 1 || SEG == 2) {
            const int hd = cc >> 6, d = cc & 63;
            float* o;
            if (row < NP) { const int b = row >> 11, t = row & 2047; o = p.out + (SEG == 1 ? O_KP : O_VP) + ((size_t)((b * 8 + hd) * 2048 + t)) * 64 + d; }
            else { const int rs = row - NP, b = rs >> 4, t = rs & 15; o = p.out + (SEG == 1 ? O_KS : O_VS) + ((size_t)((b * 8 + hd) * 16 + t)) * 64 + d; }
            __builtin_nontemporal_store(v, (f32x4*)o);
        }
        if constexpr (SEG == 0) { v = v * QSCALE; }
        if constexpr (SEG == 3 || SEG == 4) {
#pragma unroll
            for (int j = 0; j < 4; ++j) v[j] = silu(v[j]);
        }
        if constexpr (SEG == 7) {
#pragma unroll
            for (int j = 0; j < 4; ++j) v[j] = silu(v[j]) * aux[j];
        }
        constexpr size_t off = SEG == 0 ? OFF_QA : SEG == 1 ? OFF_KA : SEG == 2 ? OFF_VA : SEG == 3 ? OFF_GA : SEG == 4 ? OFF_QH : SEG == 6 ? OFF_IH : OFF_GH;
        u32x2 w; w[0] = pk_bf16(v[0], v[1]); w[1] = pk_bf16(v[2], v[3]);
        *(u32x2*)((u16*)(ws + off) + (size_t)row * 512 + cc) = w;
    }
}
template <int SEG> DI void proj_store8(const P& p, int row, int cc, f32x4 v0, f32x4 v1, f32x4 a0, f32x4 a1) {
    unsigned char* ws = p.ws;
    if constexpr (SEG == 5) {
        typedef _Float16 h16x8 __attribute__((ext_vector_type(8)));
        h16x8 g8;
#pragma unroll
        for (int j = 0; j < 4; ++j) { g8[j] = (_Float16)flog(a0[j] + (1.f - a0[j]) * sigm(v0[j])); g8[4 + j] = (_Float16)flog(a1[j] + (1.f - a1[j]) * sigm(v1[j])); }
        *(h16x8*)((_Float16*)(ws + OFF_G) + (size_t)row * 512 + cc) = g8;
    } else {
        if constexpr (SEG == 1 || SEG == 2) {
            const int hd = cc >> 6, d = cc & 63;
            float* o;
            if (row < NP) { const int b = row >> 11, t = row & 2047; o = p.out + (SEG == 1 ? O_KP : O_VP) + ((size_t)((b * 8 + hd) * 2048 + t)) * 64 + d; }
            else { const int rs = row - NP, b = rs >> 4, t = rs & 15; o = p.out + (SEG == 1 ? O_KS : O_VS) + ((size_t)((b * 8 + hd) * 16 + t)) * 64 + d; }
            __builtin_nontemporal_store(v0, (f32x4*)o); __builtin_nontemporal_store(v1, (f32x4*)(o + 4));
        }
        if constexpr (SEG == 0) { v0 = v0 * QSCALE; v1 = v1 * QSCALE; }
        if constexpr (SEG == 3 || SEG == 4) {
#pragma unroll
            for (int j = 0; j < 4; ++j) { v0[j] = silu(v0[j]); v1[j] = silu(v1[j]); }
        }
        if constexpr (SEG == 7) {
#pragma unroll
            for (int j = 0; j < 4; ++j) { v0[j] = silu(v0[j]) * a0[j]; v1[j] = silu(v1[j]) * a1[j]; }
        }
        constexpr size_t off = SEG == 0 ? OFF_QA : SEG == 1 ? OFF_KA : SEG == 2 ? OFF_VA : SEG == 3 ? OFF_GA : SEG == 4 ? OFF_QH : SEG == 6 ? OFF_IH : OFF_GH;
        u32x4 w; w[0] = pk_bf16(v0[0], v0[1]); w[1] = pk_bf16(v0[2], v0[3]); w[2] = pk_bf16(v1[0], v1[1]); w[3] = pk_bf16(v1[2], v1[3]);
        *(u32x4*)((u16*)(ws + off) + (size_t)row * 512 + cc) = w;
    }
}
struct EpiProj {
    static constexpr bool PERM = true, AFTER_DRAIN = false;
    P p;
    template <int SEG>
    DI void seg(const f32x4 (&acc)[2][2][4][2], const pg8::Unit& u, int wr, int wc, int fr, int fq) const {
        const int colt = (u.pn & 1) * 256 + wc * 32 + 8 * fq;
        f32x4 aux[2][2];
#pragma unroll
        for (int bj = 0; bj < 2; ++bj)
#pragma unroll
            for (int n = 0; n < 2; ++n) aux[bj][n] = proj_aux<SEG>(p, colt + bj * 128 + n * 4);
#pragma unroll
        for (int ai = 0; ai < 2; ++ai)
#pragma unroll
            for (int m = 0; m < 4; ++m) {
                const int row = u.pm * 256 + ai * 128 + wr * 64 + m * 16 + fr;
#pragma unroll
                for (int bj = 0; bj < 2; ++bj) proj_store8<SEG>(p, row, colt + bj * 128, acc[ai][bj][m][0], acc[ai][bj][m][1], aux[bj][0], aux[bj][1]);
            }
    }
    DI void operator()(const f32x4 (&acc)[2][2][4][2], const pg8::Unit& u, int wr, int wc, int fr, int fq) const {
        switch (u.pn >> 1) {
            case 0: seg<0>(acc, u, wr, wc, fr, fq); break;
            case 1: seg<1>(acc, u, wr, wc, fr, fq); break;
            case 2: seg<2>(acc, u, wr, wc, fr, fq); break;
            case 3: seg<3>(acc, u, wr, wc, fr, fq); break;
            case 4: seg<4>(acc, u, wr, wc, fr, fq); break;
            case 5: seg<5>(acc, u, wr, wc, fr, fq); break;
            case 6: seg<6>(acc, u, wr, wc, fr, fq); break;
            default: seg<7>(acc, u, wr, wc, fr, fq); break;
        }
    }
};
DI f32x4 slice16(const u16* arow  , const u16* brow  ) {
    f32x4 acc = {0.f, 0.f, 0.f, 0.f};
#pragma unroll 8
    for (int k0 = 0; k0 < 1024; k0 += 32) acc = __builtin_amdgcn_mfma_f32_16x16x32_bf16(*(const bf16x8*)(brow + k0), *(const bf16x8*)(arow + k0), acc, 0, 0, 0);
    return acc;
}
DI void sample_proj(const P& p) {
    const int tid_ = otid(); const int lane = tid_ & 63, wid = tid_ >> 6, fr = lane & 15, fq = lane >> 4;
    for (int cb = blockIdx.x; cb < 256; cb += gridDim.x) {
        const int row = NP + 16 * wid + fr;
        const f32x4 acc = slice16((const u16*)(p.ws + OFF_XB) + (size_t)row * 1024 + 8 * fq, (const u16*)(p.ws + OFF_WINT) + (size_t)(16 * cb + fr) * 1024 + 8 * fq);
        const int cc = ((16 * cb) & 511) + 4 * fq;
        switch (cb >> 5) {
            case 0: proj_store<0>(p, row, cc, acc, proj_aux<0>(p, cc)); break;
            case 1: proj_store<1>(p, row, cc, acc, proj_aux<1>(p, cc)); break;
            case 2: proj_store<2>(p, row, cc, acc, proj_aux<2>(p, cc)); break;
            case 3: proj_store<3>(p, row, cc, acc, proj_aux<3>(p, cc)); break;
            case 4: proj_store<4>(p, row, cc, acc, proj_aux<4>(p, cc)); break;
            case 5: proj_store<5>(p, row, cc, acc, proj_aux<5>(p, cc)); break;
            case 6: proj_store<6>(p, row, cc, acc, proj_aux<6>(p, cc)); break;
            default: proj_store<7>(p, row, cc, acc, proj_aux<7>(p, cc)); break;
        }
    }
}

struct EpiLN {
    static constexpr bool PERM = false, AFTER_DRAIN = true;
    P p;
    DI void fused(f32x4 (&acc)[2][2][4][2], const pg8::Unit& u, int wr, int wc, int fr, int fq, LAS unsigned char* lds, int tid) const {
        LAS float* red = (LAS float*)lds;
        LAS float* rowstat = (LAS float*)(lds + 8192);
        float* stats = (float*)(p.ws + OFF_STATS);
        unsigned* ctr = (unsigned*)(p.ws + OFF_CTR) + u.pm * 64;
        const int col0 = u.pn * 256 + wc * 32 + 4 * fq;
#pragma unroll
        for (int ai = 0; ai < 2; ++ai)
#pragma unroll
            for (int m = 0; m < 4; ++m) {
                const int rl = ai * 128 + wr * 64 + m * 16 + fr, row = u.pm * 256 + rl;
                const float* xr = row < NP ? p.x_prompt + (size_t)row * 1024 : p.x_sample + (size_t)((row < NTOK ? row : NP) - NP) * 1024;
                float a1 = 0.f, a2 = 0.f;
#pragma unroll
                for (int bj = 0; bj < 2; ++bj)
#pragma unroll
                    for (int n = 0; n < 2; ++n) {
                        const f32x4 xv = __builtin_nontemporal_load((const f32x4*)(xr + col0 + bj * 128 + n * 16));
                        const f32x4 v = xv * ALPHA + acc[ai][bj][m][n];
                        acc[ai][bj][m][n] = v;
                        a1 += (v[0] + v[1]) + (v[2] + v[3]);
                        a2 += (v[0] * v[0] + v[1] * v[1]) + (v[2] * v[2] + v[3] * v[3]);
                    }
                a1 += __shfl_xor(a1, 16); a2 += __shfl_xor(a2, 16);
                a1 += __shfl_xor(a1, 32); a2 += __shfl_xor(a2, 32);
                if (fq == 0) { red[(rl * 4 + wc) * 2] = a1; red[(rl * 4 + wc) * 2 + 1] = a2; }
                if (m == 3) asm volatile("" ::: "memory");
            }
        __syncthreads();
        if (tid < 256) {
            float s1 = 0.f, s2 = 0.f;
#pragma unroll
            for (int w = 0; w < 4; ++w) { s1 += red[(tid * 4 + w) * 2]; s2 += red[(tid * 4 + w) * 2 + 1]; }
            float* dst = stats + ((size_t)(u.pm * 4 + u.pn) * 256 + tid) * 2;
            __hip_atomic_store(dst, s1, __ATOMIC_RELAXED, __HIP_MEMORY_SCOPE_AGENT);
            __hip_atomic_store(dst + 1, s2, __ATOMIC_RELAXED, __HIP_MEMORY_SCOPE_AGENT);
        }
        asm volatile("s_waitcnt vmcnt(0)" ::: "memory");
        __syncthreads();
        if (tid == 0) {
            __hip_atomic_fetch_add(ctr, 1u, __ATOMIC_RELAXED, __HIP_MEMORY_SCOPE_AGENT);
            while (__hip_atomic_load(ctr, __ATOMIC_RELAXED, __HIP_MEMORY_SCOPE_AGENT) < 4u) __builtin_amdgcn_s_sleep(1);
            __builtin_amdgcn_fence(__ATOMIC_ACQUIRE, "agent");
        }
        __syncthreads();
        if (tid < 256) {
            float s1 = 0.f, s2 = 0.f;
#pragma unroll
            for (int o = 0; o < 4; ++o) {
                const float* src = stats + ((size_t)(u.pm * 4 + o) * 256 + tid) * 2;
                s1 += __hip_atomic_load(src, __ATOMIC_RELAXED, __HIP_MEMORY_SCOPE_AGENT);
                s2 += __hip_atomic_load(src + 1, __ATOMIC_RELAXED, __HIP_MEMORY_SCOPE_AGENT);
            }
            const float mean = s1 * (1.f / 1024.f);
            const float var = fmaxf(s2 * (1.f / 1024.f) - mean * mean, 0.f);
            rowstat[tid * 2] = mean; rowstat[tid * 2 + 1] = rsqrtf(var + 1e-5f);
        }
        __syncthreads();
        f32x4 gv[2][2], bv[2][2];
#pragma unroll
        for (int bj = 0; bj < 2; ++bj)
#pragma unroll
            for (int n = 0; n < 2; ++n) { gv[bj][n] = *(const f32x4*)(p.ln_g + col0 + bj * 128 + n * 16); bv[bj][n] = *(const f32x4*)(p.ln_b + col0 + bj * 128 + n * 16); }
#pragma unroll
        for (int ai = 0; ai < 2; ++ai)
#pragma unroll
            for (int m = 0; m < 4; ++m) {
                const int rl = ai * 128 + wr * 64 + m * 16 + fr, row = u.pm * 256 + rl;
                if (row >= NTOK) continue;
                const float mean = rowstat[rl * 2], rstd = rowstat[rl * 2 + 1];
                float* yr = row < NP ? p.out + O_YP + (size_t)row * 1024 : p.out + O_YS + (size_t)(row - NP) * 1024;
#pragma unroll
                for (int bj = 0; bj < 2; ++bj)
#pragma unroll
                    for (int n = 0; n < 2; ++n) __builtin_nontemporal_store((acc[ai][bj][m][n] - mean) * rstd * gv[bj][n] + bv[bj][n], (f32x4*)(yr + col0 + bj * 128 + n * 16));
                asm volatile("" ::: "memory");
            }
    }
};

DI void phase0(const P& p, unsigned char* shm) {
    const int tid = otid(), nb = gridDim.x, bid = blockIdx.x;
    u16* XB = (u16*)(p.ws + OFF_XB);
    const size_t n8p = (size_t)NP * 128, n8 = (size_t)NTOK * 128;
    const size_t stride = (size_t)nb * 512, ifirst = (size_t)bid * 512 + tid;
    float4 xa[5][4], xb[5][4];
    auto ldx = [&](int k) {
#pragma unroll
        for (int u = 0; u < 4; ++u) { const size_t i = ifirst + (size_t)(4 * k + u) * stride;
            if (i < n8) { const float4* src = (i < n8p) ? ((const float4*)p.x_prompt + 2 * i) : ((const float4*)p.x_sample + 2 * (i - n8p)); const f32x4 va = __builtin_nontemporal_load((const f32x4*)src), vb = __builtin_nontemporal_load((const f32x4*)src + 1); xa[k][u] = make_float4(va[0], va[1], va[2], va[3]); xb[k][u] = make_float4(vb[0], vb[1], vb[2], vb[3]); } }
    };
    auto stx = [&](int k) {
#pragma unroll
        for (int u = 0; u < 4; ++u) { const size_t i = ifirst + (size_t)(4 * k + u) * stride;
            if (i < n8) { uint4 o; o.x = pk_bf16(xa[k][u].x, xa[k][u].y); o.y = pk_bf16(xa[k][u].z, xa[k][u].w); o.z = pk_bf16(xb[k][u].x, xb[k][u].y); o.w = pk_bf16(xb[k][u].z, xb[k][u].w); ((uint4*)XB)[i] = o; } }
    };
    ldx(0); ldx(1);
    {
        u16* tile = (u16*)shm;
        float4 ta[5], tb[5];
        const int k = tid >> 3, n0 = (tid & 7) * 8;
#pragma unroll
        for (int i = 0; i < 5; ++i) {
            const int t = bid + i * nb;
            if (t < 1280) {
                const float* W; int N, kt, ntl;
                if (t < 1024) { W = p.w_in; N = 4096; kt = t >> 6; ntl = t & 63; } else { const int u = t - 1024; W = p.w_out; N = 1024; kt = u >> 4; ntl = u & 15; }
                const float4* s = (const float4*)(W + (size_t)(kt * 64 + k) * N + ntl * 64 + n0);
                const f32x4 va = __builtin_nontemporal_load((const f32x4*)s), vb = __builtin_nontemporal_load((const f32x4*)s + 1); ta[i] = make_float4(va[0], va[1], va[2], va[3]); tb[i] = make_float4(vb[0], vb[1], vb[2], vb[3]);
            }
        }
#pragma unroll
        for (int i = 0; i < 5; ++i) {
            const int t = bid + i * nb;
            if (t < 1280) {
                u16* WT; int kt, ntl;
                if (t < 1024) { WT = (u16*)(p.ws + OFF_WINT); kt = t >> 6; ntl = t & 63; } else { const int u = t - 1024; WT = (u16*)(p.ws + OFF_WOUTT); kt = u >> 4; ntl = u & 15; }
                const float4 a = ta[i], b = tb[i];
                tile[(n0 + 0) * 66 + k] = bf1(a.x); tile[(n0 + 1) * 66 + k] = bf1(a.y); tile[(n0 + 2) * 66 + k] = bf1(a.z); tile[(n0 + 3) * 66 + k] = bf1(a.w);
                tile[(n0 + 4) * 66 + k] = bf1(b.x); tile[(n0 + 5) * 66 + k] = bf1(b.y); tile[(n0 + 6) * 66 + k] = bf1(b.z); tile[(n0 + 7) * 66 + k] = bf1(b.w);
                lds_barrier();
                const int n = tid >> 3, k0 = (tid & 7) * 8;
                const unsigned* r = (const unsigned*)(tile + n * 66 + k0);
                uint4 o; o.x = r[0]; o.y = r[1]; o.z = r[2]; o.w = r[3];
                *(uint4*)(WT + (size_t)(ntl * 64 + n) * 1024 + kt * 64 + k0) = o;
                lds_barrier();
            }
        }
    }
    stx(0); ldx(2); stx(1); ldx(3); stx(2); ldx(4); stx(3); stx(4);
    for (int i = bid * 512 + tid; i < 16384; i += nb * 512) ((uint4*)(XB + (size_t)NTOK * 1024))[i] = make_uint4(0u, 0u, 0u, 0u);
}

template <bool SAMPLE>
DI void attn_wave(const P& p, int item, LAS unsigned char* vl, int lane) {
    const int col = lane & 31, h = lane >> 5;
    const int gi = (lane >> 4) & 1, i16 = lane & 15, tq = i16 >> 2, tp = i16 & 3;
    const u16* QA = (const u16*)(p.ws + OFF_QA);
    int b, hd, qt; size_t qrow;
    if (SAMPLE) { b = item >> 3; hd = item & 7; qt = 32; qrow = (size_t)NP + b * 16 + (col < 15 ? col : 15); }
    else { const int bh = item >> 6; qt = item & 63; b = bh >> 3; hd = bh & 7; qrow = (size_t)b * 2048 + 32 * qt + col; }
    const int qcol = SAMPLE ? (col < 15 ? col : 15) : col;
    bf16x8 qf[4];
#pragma unroll
    for (int s = 0; s < 4; ++s) qf[s] = *(const bf16x8*)(QA + qrow * 512 + hd * 64 + 16 * s + 8 * h);
    f32x16 o0, o1;
#pragma unroll
    for (int i = 0; i < 16; ++i) { o0[i] = 0.f; o1[i] = 0.f; }
    float R = 1.f;
    const u16* kbase = (const u16*)(p.ws + OFF_KA) + (size_t)b * 2048 * 512 + hd * 64;
    const u16* vbase = (const u16*)(p.ws + OFF_VA) + (size_t)b * 2048 * 512 + hd * 64;
    const float* ck = p.cache_k + (size_t)(b * 8 + hd) * 1024 * 64;
    const float* cv = p.cache_v + (size_t)(b * 8 + hd) * 1024 * 64;
    const float* nk = p.out + O_KS + (size_t)(b * 8 + hd) * 16 * 64;
    const float* nv = p.out + O_VS + (size_t)(b * 8 + hd) * 16 * 64;
    bf16x8 kn[4]; u32x4 vn[4];
    auto load_kv = [&](int j) {
        if (!SAMPLE) {
            const u16* kp = kbase + (size_t)(32 * j + col) * 512 + 8 * h;
#pragma unroll
            for (int s = 0; s < 4; ++s) kn[s] = *(const bf16x8*)(kp + 16 * s);
#pragma unroll
            for (int i = 0; i < 4; ++i) { const int c = lane + 64 * i; vn[i] = *(const u32x4*)(vbase + (size_t)(32 * j + (c >> 3)) * 512 + (c & 7) * 8); }
        } else {
            const bool fresh = (j == 32);
            const float* ksrc = fresh ? nk : ck; const float* vsrc = fresh ? nv : cv;
            const int r = fresh ? (col < 15 ? col : 15) : 32 * j + col;
            const float* kp = ksrc + (size_t)r * 64 + 8 * h;
#pragma unroll
            for (int s = 0; s < 4; ++s) kn[s] = pack8v(*(const float4*)(kp + 16 * s), *(const float4*)(kp + 16 * s + 4));
#pragma unroll
            for (int i = 0; i < 4; ++i) { const int c = lane + 64 * i; const int row = c >> 3; const int rr = fresh ? (row < 15 ? row : 15) : 32 * j + row;
                const float* vp = vsrc + (size_t)rr * 64 + (c & 7) * 8; const bf16x8 t8 = pack8v(*(const float4*)vp, *(const float4*)(vp + 4)); vn[i] = __builtin_bit_cast(u32x4, t8); }
        }
    };
    load_kv(qt);
    for (int j = qt; j >= 0; --j) {
        bf16x8 kf[4];
#pragma unroll
        for (int s = 0; s < 4; ++s) kf[s] = kn[s];
#pragma unroll
        for (int i = 0; i < 4; ++i) { const int c = lane + 64 * i; *(LAS u32x4*)(vl + (c >> 3) * 144 + (c & 7) * 16) = vn[i]; }
        if (j > 0) load_kv(j - 1);
        f32x16 st;
#pragma unroll
        for (int i = 0; i < 16; ++i) st[i] = 0.f;
        __builtin_amdgcn_s_setprio(1);
#pragma unroll
        for (int s = 0; s < 4; ++s) st = MFMA32(kf[s], qf[s], st);
        __builtin_amdgcn_s_setprio(0);
        const bool diag = (j == qt);
        float kp[16], bt[16], w[16];
#pragma unroll
        for (int i = 0; i < 16; i += 2) {
            f32x2 e2; e2[0] = ex2(fminf(st[i], 126.f)); e2[1] = ex2(fminf(st[i + 1], 126.f));
            const f32x2 d2 = e2 + 1.0f;
            f32x2 k2; k2[0] = __builtin_amdgcn_rcpf(d2[0]); k2[1] = __builtin_amdgcn_rcpf(d2[1]);
            const f32x2 b2 = e2 * k2;
            kp[i] = k2[0]; kp[i + 1] = k2[1]; bt[i] = b2[0]; bt[i + 1] = b2[1];
        }
        if (diag) {
#pragma unroll
            for (int i = 0; i < 16; ++i) if (!(crow(i, h) < qcol)) { kp[i] = 1.f; bt[i] = 0.f; }
        }
        float Go[4], Gp[4];
#pragma unroll
        for (int m = 0; m < 4; m += 2) {
            f32x2 a; a[0] = kp[4 * m]; a[1] = kp[4 * m + 4]; f32x2 b; b[0] = kp[4 * m + 1]; b[1] = kp[4 * m + 5];
            f32x2 c; c[0] = kp[4 * m + 2]; c[1] = kp[4 * m + 6]; f32x2 d; d[0] = kp[4 * m + 3]; d[1] = kp[4 * m + 7];
            const f32x2 g = (a * b) * (c * d);
            Go[m] = g[0]; Go[m + 1] = g[1];
        }
#pragma unroll
        for (int m = 0; m < 4; ++m) Gp[m] = xor32(Go[m], h);
        float bm[4]; float base = R;
#pragma unroll
        for (int m = 3; m >= 0; --m) { bm[m] = h == 0 ? base * Gp[m] : base; base *= Go[m] * Gp[m]; }
        R = base;
#pragma unroll
        for (int pr = 0; pr < 2; ++pr) {
            const int ma = 2 * pr + 1, mb = 2 * pr;
            f32x2 run; run[0] = bm[ma]; run[1] = bm[mb];
#pragma unroll
            for (int jj = 3; jj >= 0; --jj) {
                f32x2 bb; bb[0] = bt[4 * ma + jj]; bb[1] = bt[4 * mb + jj];
                const f32x2 ww = bb * run;
                w[4 * ma + jj] = ww[0]; w[4 * mb + jj] = ww[1];
                if (jj > 0) { f32x2 kk; kk[0] = kp[4 * ma + jj]; kk[1] = kp[4 * mb + jj]; run = run * kk; }
            }
        }
        const bf16x8 pw0 = pack8(w), pw1 = pack8(w + 8);
#pragma unroll
        for (int s2 = 0; s2 < 2; ++s2) {
            LAS unsigned char* lo = vl + (16 * s2 + 4 * h + tq) * 144 + (16 * gi + 4 * tp) * 2;
            const bf16x8 a0 = tr2(lo, lo + 8 * 144);
            const bf16x8 a1 = tr2(lo + 64, lo + 8 * 144 + 64);
            __builtin_amdgcn_s_setprio(1);
            o0 = MFMA32(a0, s2 ? pw1 : pw0, o0);
            o1 = MFMA32(a1, s2 ? pw1 : pw0, o1);
            __builtin_amdgcn_s_setprio(0);
        }
        if (__all(R < 1.17549435e-38f)) break;
    }
    {
#pragma unroll
        for (int dh = 0; dh < 2; ++dh)
#pragma unroll
            for (int g4 = 0; g4 < 4; ++g4) {
                f32x4 v4; v4[0] = dh ? o1[4 * g4] : o0[4 * g4]; v4[1] = dh ? o1[4 * g4 + 1] : o0[4 * g4 + 1]; v4[2] = dh ? o1[4 * g4 + 2] : o0[4 * g4 + 2]; v4[3] = dh ? o1[4 * g4 + 3] : o0[4 * g4 + 3];
                *(LAS f32x4*)(vl + col * 272 + (32 * dh + 8 * g4 + 4 * h) * 4) = v4;
            }
        asm volatile("s_waitcnt lgkmcnt(0)" ::: "memory");
#pragma unroll
        for (int i = 0; i < 4; ++i) {
            const int c = lane + 64 * i, qr = c >> 3, c8 = c & 7;
            if (!SAMPLE || qr < 16) {
                const size_t row = SAMPLE ? (size_t)NP + b * 16 + qr : (size_t)b * 2048 + 32 * qt + qr;
                const f32x4 a = *(const LAS f32x4*)(vl + qr * 272 + c8 * 32), bq = *(const LAS f32x4*)(vl + qr * 272 + c8 * 32 + 16);
                const u32x4 ga = *(const u32x4*)((const u16*)(p.ws + OFF_GA) + row * 512 + hd * 64 + c8 * 8);
                u32x4 wv;
                wv[0] = pk_bf16(a[0] * bflo(ga[0]), a[1] * bfhi(ga[0])); wv[1] = pk_bf16(a[2] * bflo(ga[1]), a[3] * bfhi(ga[1]));
                wv[2] = pk_bf16(bq[0] * bflo(ga[2]), bq[1] * bfhi(ga[2])); wv[3] = pk_bf16(bq[2] * bflo(ga[3]), bq[3] * bfhi(ga[3]));
                *(u32x4*)((u16*)(p.ws + OFF_XB) + row * 1024 + hd * 64 + c8 * 8) = wv;
            }
        }
        asm volatile("s_waitcnt lgkmcnt(0)" ::: "memory");
    }
}

struct ChunkRegs { u32x4 ih[2]; float g[16]; };
DI void chunk_load(const P& p, int ch, ChunkRegs& r) {
    const int tid = otid(), d = tid & 127, seg = tid >> 7;
    const int bh = ch >> 5, c = ch & 31, b = bh >> 2, hh = bh & 3;
    const size_t row0 = (size_t)b * 2048 + 64 * c;
    const u16* IH = (const u16*)(p.ws + OFF_IH) + row0 * 512 + hh * 128;
#pragma unroll
    for (int i = 0; i < 2; ++i) { const int cc = tid + 512 * i; r.ih[i] = *(const u32x4*)(IH + (size_t)(cc >> 4) * 512 + (cc & 15) * 8); }
    const _Float16* gp = (const _Float16*)(p.ws + OFF_G) + (row0 + 16 * seg) * 512 + hh * 128 + d;
#pragma unroll
    for (int i = 0; i < 16; ++i) r.g[i] = (float)gp[(size_t)i * 512];
}
DI void chunk_cumsum(const float (&gv)[16], float (&bc)[16], LAS float* segsum, int d, int seg, float& off, float& tot) {
    float run = 0.f;
#pragma unroll
    for (int i = 0; i < 16; ++i) { run += gv[i]; bc[i] = run; }
    segsum[seg * 128 + d] = run;
    lds_barrier();
    off = 0.f; tot = 0.f;
#pragma unroll
    for (int s4 = 0; s4 < 4; ++s4) { const float x = segsum[s4 * 128 + d]; tot += x; off += (s4 < seg) ? x : 0.f; }
}

DI void hgrn_local(const P& p, int ch, const ChunkRegs& r, LAS unsigned char* L) {
    const int tid = otid(), wid = tid >> 6, lane = tid & 63;
    LAS float* segsum = (LAS float*)L;
    LAS unsigned char* KT = L + 2048;
    LAS unsigned char* II = L + 2048 + 18432;
    LAS unsigned char* OUTS = L + 2048 + 18432 + 17408;
    const int d = tid & 127, seg = tid >> 7;
    float bc[16], off, tot;
#pragma unroll
    for (int i = 0; i < 2; ++i) { const int cc = tid + 512 * i; *(LAS u32x4*)(II + (cc >> 4) * 272 + (cc & 15) * 16) = r.ih[i]; }
    chunk_cumsum(r.g, bc, segsum, d, seg, off, tot);
    {
        float kx[16];
#pragma unroll
        for (int i = 0; i < 16; ++i) kx[i] = (1.f - __expf(r.g[i])) * __expf(tot - (off + bc[i]));
        *(LAS bf16x8*)(KT + d * 144 + seg * 32) = pack8(kx);
        *(LAS bf16x8*)(KT + d * 144 + seg * 32 + 16) = pack8(kx + 8);
        if (seg == 0) ((float*)(p.ws + OFF_BLAST))[(size_t)ch * 128 + d] = tot;
    }
    lds_barrier();
    {
        const int col = lane & 31, h = lane >> 5, gi = (lane >> 4) & 1, i16 = lane & 15, tq = i16 >> 2, tp = i16 & 3;
        const int vt = wid >> 1, dt0 = 2 * (wid & 1);
        f32x16 a0, a1;
#pragma unroll
        for (int i = 0; i < 16; ++i) { a0[i] = 0.f; a1[i] = 0.f; }
#pragma unroll
        for (int ks = 0; ks < 4; ++ks) {
            LAS unsigned char* lo = II + (16 * ks + 8 * h + tq) * 272 + (32 * vt + 16 * gi + 4 * tp) * 2;
            const bf16x8 A = tr2(lo, lo + 4 * 272);
            const bf16x8 B0 = *(const LAS bf16x8*)(KT + (32 * dt0 + col) * 144 + (16 * ks + 8 * h) * 2);
            const bf16x8 B1 = *(const LAS bf16x8*)(KT + (32 * (dt0 + 1) + col) * 144 + (16 * ks + 8 * h) * 2);
            a0 = MFMA32(A, B0, a0); a1 = MFMA32(A, B1, a1);
        }
#pragma unroll
        for (int i = 0; i < 16; ++i) {
            const int v = 32 * vt + crow(i, h);
            *(LAS u16*)(OUTS + v * 272 + (32 * dt0 + col) * 2) = bf1(a0[i]);
            *(LAS u16*)(OUTS + v * 272 + (32 * (dt0 + 1) + col) * 2) = bf1(a1[i]);
        }
    }
    lds_barrier();
    {
        u16* SL = (u16*)(p.ws + OFF_SLOC) + (size_t)ch * 16384;
#pragma unroll
        for (int i = 0; i < 4; ++i) { const int cc = tid + 512 * i; const int rr = cc >> 4, c16 = cc & 15; *(u32x4*)(SL + rr * 128 + c16 * 8) = *(const LAS u32x4*)(OUTS + rr * 272 + c16 * 16); }
    }
}

DI void hgrn_scan(const P& p, int first_block) {
    const int nthreads = ((int)gridDim.x - first_block) * 512, t0 = ((int)blockIdx.x - first_block) * 512 + otid();
    for (int gidx = t0; gidx < 65536; gidx += nthreads) {
        const int dg = gidx & 15, v = (gidx >> 4) & 127, bh = gidx >> 11;
        float S[8];
#pragma unroll
        for (int j = 0; j < 8; ++j) S[j] = 0.f;
        u16* base = (u16*)(p.ws + OFF_SLOC) + ((size_t)bh * 32 * 128 + v) * 128 + dg * 8;
        const float* bl = (const float*)(p.ws + OFF_BLAST) + (size_t)bh * 32 * 128 + dg * 8;
        for (int cb = 0; cb < 32; cb += 8) {
            u32x4 raw[8]; f32x4 d0[8], d1[8];
#pragma unroll
            for (int u = 0; u < 8; ++u) { raw[u] = *(const u32x4*)(base + (size_t)(cb + u) * 16384); d0[u] = *(const f32x4*)(bl + (cb + u) * 128); d1[u] = *(const f32x4*)(bl + (cb + u) * 128 + 4); }
#pragma unroll
            for (int u = 0; u < 8; ++u) {
                u32x4 o; o[0] = pk_bf16(S[0], S[1]); o[1] = pk_bf16(S[2], S[3]); o[2] = pk_bf16(S[4], S[5]); o[3] = pk_bf16(S[6], S[7]);
                *(u32x4*)(base + (size_t)(cb + u) * 16384) = o;
#pragma unroll
                for (int j = 0; j < 4; ++j) {
                    S[2 * j] = S[2 * j] * __expf(j < 2 ? d0[u][2 * j] : d1[u][2 * j - 4]) + bflo(raw[u][j]);
                    S[2 * j + 1] = S[2 * j + 1] * __expf(j < 2 ? d0[u][2 * j + 1] : d1[u][2 * j - 3]) + bfhi(raw[u][j]);
                }
            }
        }
        float* os = p.out + O_SP + ((size_t)bh * 128 + dg * 8) * 128 + v;
#pragma unroll
        for (int j = 0; j < 8; ++j) os[(size_t)j * 128] = S[j];
    }
}

struct OutRegs { ChunkRegs c; u16 q[16]; };
DI void out_load(const P& p, int ch, OutRegs& r) {
    chunk_load(p, ch, r.c);
    const int tid = otid(), d = tid & 127, seg = tid >> 7;
    const int bh = ch >> 5, c = ch & 31, b = bh >> 2, hh = bh & 3;
    const u16* QH = (const u16*)(p.ws + OFF_QH) + ((size_t)b * 2048 + 64 * c + 16 * seg) * 512 + hh * 128 + d;
#pragma unroll
    for (int i = 0; i < 16; ++i) r.q[i] = QH[(size_t)i * 512];
}
DI void hgrn_out(const P& p, int ch, const OutRegs& r, LAS unsigned char* L) {
    const int tid = otid(), wid = tid >> 6, lane = tid & 63;
    const int bh = ch >> 5, c = ch & 31, b = bh >> 2, hh = bh & 3;
    const size_t row0 = (size_t)b * 2048 + 64 * c;
    LAS float* segsum = (LAS float*)L;
    LAS unsigned char* QE = L + 2048;
    LAS unsigned char* KE = L + 2048 + 17408;
    LAS unsigned char* II = L + 2048 + 2 * 17408;
    LAS float* ssq = (LAS float*)(L + 2048 + 3 * 17408);
    const int d = tid & 127, seg = tid >> 7;
    const int col = lane & 31, h = lane >> 5, gi = (lane >> 4) & 1, i16 = lane & 15, tq = i16 >> 2, tp = i16 & 3;
    const int vi = wid & 3, ti = wid >> 2;
    bf16x8 sa[8]; u32x4 gh[2];
    {
        const u16* S0 = (const u16*)(p.ws + OFF_SLOC) + (size_t)ch * 16384 + (size_t)(32 * vi + col) * 128 + 8 * h;
#pragma unroll
        for (int kd = 0; kd < 8; ++kd) sa[kd] = *(const bf16x8*)(S0 + 16 * kd);
        const u16* GH = (const u16*)(p.ws + OFF_GH) + (row0 + (tid >> 3)) * 512 + hh * 128 + (tid & 7) * 16;
        gh[0] = *(const u32x4*)GH; gh[1] = *(const u32x4*)(GH + 8);
    }
    float bc[16], off, tot;
#pragma unroll
    for (int i = 0; i < 2; ++i) { const int cc = tid + 512 * i; *(LAS u32x4*)(II + (cc >> 4) * 272 + (cc & 15) * 16) = r.c.ih[i]; }
    chunk_cumsum(r.c.g, bc, segsum, d, seg, off, tot);
#pragma unroll
    for (int i = 0; i < 16; ++i) {
        const float bb = off + bc[i];
        const int s = 16 * seg + i;
        *(LAS u16*)(QE + s * 272 + d * 2) = bf1(bf2f(r.q[i]) * __expf(bb));
        *(LAS u16*)(KE + s * 272 + d * 2) = bf1((1.f - __expf(r.c.g[i])) * __expf(fminf(-bb, 80.f)));
    }
    lds_barrier();
    bf16x8 qf[8];
#pragma unroll
    for (int kd = 0; kd < 8; ++kd) qf[kd] = *(const LAS bf16x8*)(QE + (32 * ti + col) * 272 + (16 * kd + 8 * h) * 2);
    f32x16 o;
#pragma unroll
    for (int i = 0; i < 16; ++i) o[i] = 0.f;
#pragma unroll
    for (int kd = 0; kd < 8; ++kd) o = MFMA32(sa[kd], qf[kd], o);
#pragma unroll
    for (int si = 0; si < 2; ++si) {
        if (si <= ti) {
            f32x16 pt;
#pragma unroll
            for (int i = 0; i < 16; ++i) pt[i] = 0.f;
#pragma unroll
            for (int kd = 0; kd < 8; ++kd) { const bf16x8 ka = *(const LAS bf16x8*)(KE + (32 * si + col) * 272 + (16 * kd + 8 * h) * 2); pt = MFMA32(ka, qf[kd], pt); }
            float w[16];
#pragma unroll
            for (int i = 0; i < 16; ++i) w[i] = (si < ti || crow(i, h) <= col) ? pt[i] : 0.f;
            const bf16x8 pw0 = pack8(w), pw1 = pack8(w + 8);
#pragma unroll
            for (int s2 = 0; s2 < 2; ++s2) {
                LAS unsigned char* lo = II + (32 * si + 16 * s2 + 4 * h + tq) * 272 + (32 * vi + 16 * gi + 4 * tp) * 2;
                const bf16x8 A = tr2(lo, lo + 8 * 272);
                o = MFMA32(A, s2 ? pw1 : pw0, o);
            }
        }
    }
    {
        float ss = 0.f;
#pragma unroll
        for (int i = 0; i < 16; ++i) ss += o[i] * o[i];
        ss += __shfl_xor(ss, 32);
        if (h == 0) ssq[(32 * ti + col) * 4 + vi] = ss;
    }
    lds_barrier();
    {
        LAS unsigned char* OT = L + 2048;
        const int t = 32 * ti + col;
        const float tot2 = (ssq[t * 4] + ssq[t * 4 + 1]) + (ssq[t * 4 + 2] + ssq[t * 4 + 3]);
        const float rs = rsqrtf(tot2 * (1.f / 128.f) + 1e-6f);
#pragma unroll
        for (int g4 = 0; g4 < 4; ++g4) {
            f32x4 v4; v4[0] = o[4 * g4] * rs; v4[1] = o[4 * g4 + 1] * rs; v4[2] = o[4 * g4 + 2] * rs; v4[3] = o[4 * g4 + 3] * rs;
            *(LAS f32x4*)(OT + t * 528 + (32 * vi + 8 * g4 + 4 * h) * 4) = v4;
        }
        lds_barrier();
        const int tr_ = tid >> 3, c16 = tid & 7;
        f32x4 a[4];
#pragma unroll
        for (int q4 = 0; q4 < 4; ++q4) a[q4] = *(const LAS f32x4*)(OT + tr_ * 528 + c16 * 64 + q4 * 16);
        u32x4 w0, w1;
        w0[0] = pk_bf16(a[0][0] * bflo(gh[0][0]), a[0][1] * bfhi(gh[0][0])); w0[1] = pk_bf16(a[0][2] * bflo(gh[0][1]), a[0][3] * bfhi(gh[0][1]));
        w0[2] = pk_bf16(a[1][0] * bflo(gh[0][2]), a[1][1] * bfhi(gh[0][2])); w0[3] = pk_bf16(a[1][2] * bflo(gh[0][3]), a[1][3] * bfhi(gh[0][3]));
        w1[0] = pk_bf16(a[2][0] * bflo(gh[1][0]), a[2][1] * bfhi(gh[1][0])); w1[1] = pk_bf16(a[2][2] * bflo(gh[1][1]), a[2][3] * bfhi(gh[1][1]));
        w1[2] = pk_bf16(a[3][0] * bflo(gh[1][2]), a[3][1] * bfhi(gh[1][2])); w1[3] = pk_bf16(a[3][2] * bflo(gh[1][3]), a[3][3] * bfhi(gh[1][3]));
        u16* MX = (u16*)(p.ws + OFF_XB) + (row0 + tr_) * 1024 + 512 + hh * 128 + c16 * 16;
        *(u32x4*)MX = w0; *(u32x4*)(MX + 8) = w1;
    }
}

DI void sample_hgrn(const P& p, int bh, unsigned char* shm) {
    const int tid = otid(), b = bh >> 2, hh = bh & 3;
    float* F = (float*)shm; float* Q = F + 2048; float* I = Q + 2048; float* PART = I + 2048; float* O = PART + 8192;
    for (int e = tid; e < 2048; e += 512) {
        const int t = e >> 7, c = e & 127; const size_t off = (size_t)(NP + b * 16 + t) * 512 + hh * 128 + c;
        F[e] = __expf((float)((const _Float16*)(p.ws + OFF_G))[off]); Q[e] = bf2f(((const u16*)(p.ws + OFF_QH))[off]); I[e] = bf2f(((const u16*)(p.ws + OFF_IH))[off]);
    }
    const int v = tid & 127, dq = tid >> 7;
    float S[32];
#pragma unroll
    for (int dd = 0; dd < 32; ++dd) S[dd] = p.state_s[((size_t)bh * 128 + 32 * dq + dd) * 128 + v];
    lds_barrier();
    for (int t = 0; t < 16; ++t) {
        const float iv = I[t * 128 + v]; float po = 0.f;
        const float4* Fv = (const float4*)(F + t * 128 + 32 * dq); const float4* Qv = (const float4*)(Q + t * 128 + 32 * dq);
#pragma unroll
        for (int d4 = 0; d4 < 8; ++d4) {
            const float4 f = Fv[d4], q = Qv[d4];
            S[4 * d4] = f.x * S[4 * d4] + (1.f - f.x) * iv; po += S[4 * d4] * q.x;
            S[4 * d4 + 1] = f.y * S[4 * d4 + 1] + (1.f - f.y) * iv; po += S[4 * d4 + 1] * q.y;
            S[4 * d4 + 2] = f.z * S[4 * d4 + 2] + (1.f - f.z) * iv; po += S[4 * d4 + 2] * q.z;
            S[4 * d4 + 3] = f.w * S[4 * d4 + 3] + (1.f - f.w) * iv; po += S[4 * d4 + 3] * q.w;
        }
        PART[(dq * 16 + t) * 128 + v] = po;
    }
    lds_barrier();
    for (int e = tid; e < 2048; e += 512) O[e] = (PART[e] + PART[2048 + e]) + (PART[4096 + e] + PART[6144 + e]);
    lds_barrier();
#pragma unroll
    for (int dd = 0; dd < 32; ++dd) p.out[O_SS + ((size_t)bh * 128 + 32 * dq + dd) * 128 + v] = S[dd];
    {
        const int t = tid >> 5, l32 = tid & 31;
        const float4 o = *(const float4*)(O + t * 128 + l32 * 4);
        float ss = (o.x * o.x + o.y * o.y) + (o.z * o.z + o.w * o.w);
        ss += __shfl_xor(ss, 16); ss += __shfl_xor(ss, 8); ss += __shfl_xor(ss, 4); ss += __shfl_xor(ss, 2); ss += __shfl_xor(ss, 1);
        const float rs = rsqrtf(ss * (1.f / 128.f) + 1e-6f);
        const size_t row = (size_t)NP + b * 16 + t;
        const u32x2 gh = *(const u32x2*)((const u16*)(p.ws + OFF_GH) + row * 512 + hh * 128 + l32 * 4);
        u32x2 wv; wv[0] = pk_bf16(o.x * rs * bflo(gh[0]), o.y * rs * bfhi(gh[0])); wv[1] = pk_bf16(o.z * rs * bflo(gh[1]), o.w * rs * bfhi(gh[1]));
        *(u32x2*)((u16*)(p.ws + OFF_XB) + row * 1024 + 512 + hh * 128 + l32 * 4) = wv;
    }
}

DI void sample_out_proj(const P& p, int cb) {
    const int tid_ = otid(); const int lane = tid_ & 63, wid = tid_ >> 6, fr = lane & 15, fq = lane >> 4;
    const int r = 16 * wid + fr;
    const f32x4 acc = slice16((const u16*)(p.ws + OFF_XB) + (size_t)(NP + r) * 1024 + 8 * fq, (const u16*)(p.ws + OFF_WOUTT) + (size_t)(16 * cb + fr) * 1024 + 8 * fq);
    *(f32x4*)((float*)(p.ws + OFF_PRE) + (size_t)r * 1024 + 16 * cb + 4 * fq) = acc;
}
DI void sample_ln(const P& p, int r, int lane) {
    const float* xr = p.x_sample + (size_t)r * 1024; const float* pr = (const float*)(p.ws + OFF_PRE) + (size_t)r * 1024;
    f32x4 v[4]; float s = 0.f;
#pragma unroll
    for (int i = 0; i < 4; ++i) { v[i] = *(const f32x4*)(xr + 256 * i + 4 * lane) * ALPHA + *(const f32x4*)(pr + 256 * i + 4 * lane); s += (v[i][0] + v[i][1]) + (v[i][2] + v[i][3]); }
#pragma unroll
    for (int o = 32; o >= 1; o >>= 1) s += __shfl_xor(s, o);
    const float mean = s * (1.f / 1024.f); float q = 0.f;
#pragma unroll
    for (int i = 0; i < 4; ++i) { const f32x4 dd = v[i] - mean; q += (dd[0] * dd[0] + dd[1] * dd[1]) + (dd[2] * dd[2] + dd[3] * dd[3]); }
#pragma unroll
    for (int o = 32; o >= 1; o >>= 1) q += __shfl_xor(q, o);
    const float rstd = rsqrtf(q * (1.f / 1024.f) + 1e-5f);
    float* yr = p.out + O_YS + (size_t)r * 1024;
#pragma unroll
    for (int i = 0; i < 4; ++i) *(f32x4*)(yr + 256 * i + 4 * lane) = (v[i] - mean) * rstd * *(const f32x4*)(p.ln_g + 256 * i + 4 * lane) + *(const f32x4*)(p.ln_b + 256 * i + 4 * lane);
}

__global__ void __launch_bounds__(512, 2) mega(P p) {
    extern __shared__ __attribute__((aligned(16))) unsigned char shm[];
    LAS unsigned char* L = (LAS unsigned char*)shm;
    cg::grid_group grid = cg::this_grid();
    const int G = (int)gridDim.x, bid = (int)blockIdx.x;
    const bool multi = (p.ph_hi - p.ph_lo) > 1;
    volatile LAS unsigned* bst = (volatile LAS unsigned*)(L + 131072);
    if (threadIdx.x == 0) { bst[0] = 0u; bst[1] = 0u; }
    __syncthreads();
    const XcdBarrier xbar = xcd_barrier_post((unsigned*)(p.ws + OFF_BAR), bst);
#define GSYNC() do { if (p.ph_hi > 100) grid.sync(); else xcd_barrier(xbar); } while (0)
    unsigned long long tm0 = (TIMER_PH == 0) ? wall_clock64() : 0ull, tm1 = 0ull;
#define PH_ON(n) (p.ph_lo <= (n) && (n) < p.ph_hi && (PHMASK & (1 << (n))))
#define PH_SYNC(n) do { if (TIMER_PH == (n) && TIMER_PRE) tm1 = wall_clock64(); if (multi && p.ph_lo <= (n) && (n) + 1 < p.ph_hi) GSYNC(); if (TIMER_PH >= 0 && !(TIMER_PH == (n) && TIMER_PRE)) { const unsigned long long t_ = wall_clock64(); if (TIMER_PH == (n) + 1) tm0 = t_; if (TIMER_PH == (n)) tm1 = t_; } } while (0)
    REPS(0) { if (PH_ON(0)) phase0(p, shm); if (REP_PH == 0 && rep_ == 0) GSYNC(); }
    PH_SYNC(0);
    REPS(1) { if (REP_PH == 1 && rep_ == 1) GSYNC();
    if (PH_ON(1)) {
        pg8::StaticOrder S; S.init(NP, 4096, G, bid);
        pg8::Gemm g; g.A = (const u16*)(p.ws + OFF_XB); g.Bt = (const u16*)(p.ws + OFF_WINT); g.M = NP; g.N = 4096; g.K = 1024;
        EpiProj E; E.p = p;
        pg8::gemm_phase<EpiProj, pg8::StaticOrder>(L, g, S, E);
        sample_proj(p);
    } }
    PH_SYNC(1);
    REPS(2) { if (REP_PH == 2 && rep_ == 1) GSYNC();
    if (PH_ON(2)) {
        const int t2_ = otid(), wid2 = t2_ >> 6, lane2 = t2_ & 63;
        if (bid < 32) { sample_hgrn(p, bid, shm); lds_barrier(); }
        if (bid >= 32 && bid < 96 && wid2 == 0) {
            attn_wave<true>(p, bid - 32, L + wid2 * 9216, lane2);
        } else {
            const int r = bid < 32 ? bid * 8 + wid2 : (bid < 96 ? 256 + (bid - 32) * 7 + (wid2 - 1) : 704 + (bid - 96) * 8 + wid2);
            const int nit = (bid >= 96 && bid < 224 && wid2 == 1) ? 3 : 2;
            for (int q = 0; q < nit; ++q) attn_wave<false>(p, q == 0 ? r : (q == 1 ? r + 1984 : 3968 + (bid - 96)), L + wid2 * 9216, lane2);
        }
        ChunkRegs cur;
        if (bid < 1024) chunk_load(p, bid, cur);
        for (int ch = bid; ch < 1024; ch += G) {
            ChunkRegs nxt;
            const bool hn = ch + G < 1024;
            if (hn) chunk_load(p, ch + G, nxt);
            lds_barrier();
            hgrn_local(p, ch, cur, L);
            if (hn) cur = nxt;
        }
    } }
    PH_SYNC(2);
    if (PH_ON(3)) {
        if (bid < 64) sample_out_proj(p, bid);
        else hgrn_scan(p, 64);
    }
    PH_SYNC(3);
    REPS(4) { if (REP_PH == 4 && rep_ == 1) GSYNC();
    if (PH_ON(4)) {
        OutRegs cur;
        if (bid < 1024) out_load(p, bid, cur);
        for (int ch = bid; ch < 1024; ch += G) {
            OutRegs nxt;
            const bool hn = ch + G < 1024;
            if (hn) out_load(p, ch + G, nxt);
            lds_barrier();
            hgrn_out(p, ch, cur, L);
            if (hn) cur = nxt;
        }
    } }
    PH_SYNC(4);
    REPS(5) { if (REP_PH == 5 && rep_ == 1) GSYNC();
    if (PH_ON(5)) {
        if (bid < 16) { const int t_ = otid(); sample_ln(p, bid * 8 + (t_ >> 6), t_ & 63); }
        pg8::SingleUnit S; S.pm = bid & 63; S.pn = bid >> 6;
        pg8::Gemm g; g.A = (const u16*)(p.ws + OFF_XB); g.Bt = (const u16*)(p.ws + OFF_WOUTT); g.M = NP; g.N = 1024; g.K = 1024;
        EpiLN E; E.p = p;
        pg8::gemm_phase<EpiLN, pg8::SingleUnit>(L, g, S, E);
    } }
    if (TIMER_PH >= 0) {
        if (TIMER_PH == 5) { GSYNC(); tm1 = wall_clock64(); }
        if (bid == 0) {
            const float delta = (float)(tm1 - tm0) * 0.01f * (1.f / 300.f);
            for (int i = otid(); i < 65536; i += 512) p.out[O_KS + i] *= (1.f + delta);
        }
    }
}

extern "C" void kernel_launch(void* const* d_in, const int* in_sizes, int n_in, void* d_out, int out_size, void* d_ws, size_t ws_size, hipStream_t stream) {
    static int grid = 0;
    if (grid == 0) {
        int dev = 0, cus = 0, per_cu = 0;
        (void)hipGetDevice(&dev);
        (void)hipDeviceGetAttribute(&cus, hipDeviceAttributeMultiprocessorCount, dev);
        (void)hipFuncSetAttribute((const void*)mega, hipFuncAttributeMaxDynamicSharedMemorySize, LDS_BYTES);
        (void)hipOccupancyMaxActiveBlocksPerMultiprocessor(&per_cu, (const void*)mega, 512, LDS_BYTES);
        grid = cus * per_cu;
        if (grid > 256) grid = 256;
        if (grid != 256 || ws_size < WS_END) { fprintf(stderr, "kernel_launch: needs 256 co-resident workgroups (got %d x %d) and %zu B of workspace (got %zu)\n", cus, per_cu, (size_t)WS_END, ws_size); }
    }
    (void)hipMemsetAsync((unsigned char*)d_ws + OFF_CTR, 0, SZ_ZERO, stream);
    P p{};
    p.x_prompt = (const float*)d_in[0]; p.x_sample = (const float*)d_in[1]; p.cache_k = (const float*)d_in[2]; p.cache_v = (const float*)d_in[3];
    p.state_s = (const float*)d_in[4]; p.w_in = (const float*)d_in[5]; p.w_out = (const float*)d_in[6]; p.lb_logits = (const float*)d_in[7];
    p.norm_g = (const float*)d_in[8]; p.ln_g = (const float*)d_in[9]; p.ln_b = (const float*)d_in[10];
    p.out = (float*)d_out; p.ws = (unsigned char*)d_ws; p.ph_lo = 0; p.ph_hi = 6;
    void* args[] = {&p};
    hipError_t e = hipLaunchCooperativeKernel((const void*)mega, dim3(grid), dim3(512), args, LDS_BYTES, stream);
    if (e != hipSuccess) fprintf(stderr, "cooperative launch failed: %s (grid %d)\n", hipGetErrorString(e), grid);
}
```

```cpp
#include <hip/hip_runtime.h>
#include <cstdio>

#define DI __device__ __forceinline__
#define LAS __attribute__((address_space(3)))
typedef unsigned short u16;
typedef short bf16x8 __attribute__((ext_vector_type(8)));
typedef short s16x4 __attribute__((ext_vector_type(4)));
typedef float f32x4 __attribute__((ext_vector_type(4)));
typedef float f32x2 __attribute__((ext_vector_type(2)));
typedef float f32x16 __attribute__((ext_vector_type(16)));
typedef unsigned u32x4 __attribute__((ext_vector_type(4)));
typedef unsigned u32x2 __attribute__((ext_vector_type(2)));
typedef __bf16 bf16x2_t __attribute__((ext_vector_type(2)));

constexpr int NP = 16384;
constexpr int NTOK = 16512;
constexpr int MPAD = 16640;
constexpr float ALPHA = 1.189207115002721f;
constexpr float QSCALE = 0.18033688011112042f;

constexpr size_t O_YP = 0, O_YS = 16777216, O_KP = 16908288, O_VP = 25296896, O_SP = 33685504, O_KS = 34209792, O_VS = 34275328, O_SS = 34340864;

constexpr size_t SZ_XB = (size_t)MPAD * 1024 * 2;
constexpr size_t SZ_H = (size_t)MPAD * 512 * 2;
constexpr size_t OFF_XB = 0;
constexpr size_t OFF_WINT = OFF_XB + SZ_XB;
constexpr size_t OFF_WOUTT = OFF_WINT + (size_t)4096 * 1024 * 2;
constexpr size_t OFF_QA = OFF_WOUTT + (size_t)1024 * 1024 * 2;
constexpr size_t OFF_KA = OFF_QA + SZ_H;
constexpr size_t OFF_VA = OFF_KA + SZ_H;
constexpr size_t OFF_GA = OFF_VA + SZ_H;
constexpr size_t OFF_QH = OFF_GA + SZ_H;
constexpr size_t OFF_IH = OFF_QH + SZ_H;
constexpr size_t OFF_GH = OFF_IH + SZ_H;
constexpr size_t OFF_G = OFF_GH + SZ_H;
constexpr size_t OFF_SLOC = OFF_G + (size_t)MPAD * 512 * 4;
constexpr size_t OFF_BLAST = OFF_SLOC + (size_t)1024 * 16384 * 2;
constexpr size_t OFF_STATS = OFF_BLAST + (size_t)1024 * 128 * 4;
constexpr size_t OFF_CTR = OFF_STATS + (size_t)65 * 4 * 256 * 2 * 4;
constexpr size_t SZ_CTR = 65 * 64 * 4;
constexpr size_t OFF_BAR = OFF_CTR + 16896;
constexpr size_t SZ_ZERO = 16896 + 14080;
constexpr size_t OFF_PRE = OFF_BAR + 14080;
constexpr size_t WS_END = OFF_PRE + (size_t)128 * 1024 * 4;
constexpr int LDS_BYTES = 131072 + 16;
#ifndef PHMASK
#define PHMASK 63
#endif
#ifndef REP_PH
#define REP_PH -1
#endif
#ifndef TIMER_PH
#define TIMER_PH -1
#endif
#ifndef TIMER_PRE
#define TIMER_PRE 0
#endif
#define REPS(n) for (int rep_ = 0; rep_ < ((n) == REP_PH ? 2 : 1); ++rep_)

struct P {
    const float *x_prompt, *x_sample, *cache_k, *cache_v, *state_s, *w_in, *w_out, *lb_logits, *norm_g, *ln_g, *ln_b;
    float* out;
    unsigned char* ws;
    int ph_lo, ph_hi;
};

DI unsigned pk_bf16(float lo, float hi) { f32x2 v = {lo, hi}; bf16x2_t b = __builtin_convertvector(v, bf16x2_t); return __builtin_bit_cast(unsigned, b); }
DI u16 bf1(float x) { return (u16)(pk_bf16(x, 0.f) & 0xffffu); }
DI float bf2f(u16 v) { return __uint_as_float(((unsigned)v) << 16); }
DI float bflo(unsigned v) { return __uint_as_float(v << 16); }
DI float bfhi(unsigned v) { return __uint_as_float(v & 0xffff0000u); }
DI float ex2(float x) { return __builtin_amdgcn_exp2f(x); }
DI float lg2(float x) { return __builtin_amdgcn_logf(x); }
DI float sigm(float x) { return __builtin_amdgcn_rcpf(1.f + ex2(-1.4426950408889634f * x)); }
DI float silu(float x) { return x * __builtin_amdgcn_rcpf(1.f + ex2(-1.4426950408889634f * x)); }
DI float fexp(float x) { return ex2(1.4426950408889634f * x); }
DI float flog(float x) { return 0.6931471805599453f * lg2(x); }
DI int otid() { int t = threadIdx.x; asm volatile("" : "+v"(t)); return t; }
DI void lds_barrier() { asm volatile("s_waitcnt lgkmcnt(0)" ::: "memory"); __builtin_amdgcn_s_barrier(); asm volatile("" ::: "memory"); }
DI float xor32(float x, int h) { const auto r = __builtin_amdgcn_permlane32_swap(__float_as_uint(x), __float_as_uint(x), false, false); return __uint_as_float(h ? r[0] : r[1]); }
DI int crow(int i, int h) { return (i & 3) + 8 * (i >> 2) + 4 * h; }
DI bf16x8 pack8(const float* w) { u32x4 r; r[0] = pk_bf16(w[0], w[1]); r[1] = pk_bf16(w[2], w[3]); r[2] = pk_bf16(w[4], w[5]); r[3] = pk_bf16(w[6], w[7]); return __builtin_bit_cast(bf16x8, r); }
DI bf16x8 pack8v(float4 a, float4 b) { u32x4 r; r[0] = pk_bf16(a.x, a.y); r[1] = pk_bf16(a.z, a.w); r[2] = pk_bf16(b.x, b.y); r[3] = pk_bf16(b.z, b.w); return __builtin_bit_cast(bf16x8, r); }
DI bf16x8 tr2(LAS unsigned char* lo, LAS unsigned char* hi) {
    s16x4 a = __builtin_amdgcn_ds_read_tr16_b64_v4i16((LAS s16x4*)lo);
    s16x4 b = __builtin_amdgcn_ds_read_tr16_b64_v4i16((LAS s16x4*)hi);
    return __builtin_shufflevector(a, b, 0, 1, 2, 3, 4, 5, 6, 7);
}
#define MFMA32(a, b, c) __builtin_amdgcn_mfma_f32_32x32x16_bf16((a), (b), (c), 0, 0, 0)


#define XB_TMO      128
#define XB_XCNT(j)  (256  + 64 * (j))
#define XB_XSUB(j)  (1280 + 64 * (j))
#define XB_XGEN(j)  (2304 + 64 * (j))
#define XB_TOP      3328
#define XB_TOPGEN   3392
#define XCD_BAR_WORDS 3456
#define XB_SPIN_CAP (1u << 18)
DI unsigned xb_ld(unsigned* p)              { return __hip_atomic_load(p, __ATOMIC_RELAXED, __HIP_MEMORY_SCOPE_AGENT); }
DI unsigned xb_add(unsigned* p, unsigned v) { return __hip_atomic_fetch_add(p, v, __ATOMIC_RELAXED, __HIP_MEMORY_SCOPE_AGENT); }
DI unsigned xb_xcc_id() { return (unsigned)__builtin_amdgcn_s_getreg((3 << 11) | 20) & 0xFu; }
#define XB_SPIN(cond, bar) do { unsigned _sp = 0; while (cond) { __builtin_amdgcn_s_sleep(1); \
    if ((++_sp & 255u) == 0u) { if (xb_ld(&(bar)[XB_TMO])) break; if (_sp > XB_SPIN_CAP) { atomicAdd(&(bar)[XB_TMO], 1u); break; } } } } while (0)
struct XcdBarrier { unsigned* bar; unsigned x; volatile LAS unsigned* st; };
DI XcdBarrier xcd_barrier_post(unsigned* bar, volatile LAS unsigned* st) {
    XcdBarrier b; b.bar = bar; b.x = xb_xcc_id(); b.st = st;
    if (threadIdx.x == 0) (void)xb_add(&bar[XB_XCNT(b.x)], 1u);
    return b;
}
DI void xcd_barrier_complete(unsigned* bar, unsigned x, unsigned& nloc, unsigned& nx) {
    const unsigned G = gridDim.x * gridDim.y * gridDim.z;
    unsigned sum, cnt, mine, sp = 0u;
    for (;;) {
        sum = 0u; cnt = 0u; mine = 0u;
#pragma unroll
        for (unsigned j = 0; j < 16; ++j) { const unsigned c = xb_ld(&bar[XB_XCNT(j)]); sum += c; cnt += (c > 0u) ? 1u : 0u; mine = (j == x) ? c : mine; }
        if (sum == G) break;
        __builtin_amdgcn_s_sleep(1);
        if ((++sp & 255u) == 0u) { if (xb_ld(&bar[XB_TMO])) break; if (sp > XB_SPIN_CAP) { atomicAdd(&bar[XB_TMO], 1u); break; } }
    }
    nloc = mine > 0u ? mine : 1u; nx = cnt > 0u ? cnt : 1u;
}
DI void xcd_barrier(const XcdBarrier& b) {
    asm volatile("s_waitcnt vmcnt(0)" ::: "memory");
    __syncthreads();
    if (threadIdx.x == 0) {
        unsigned* bar = b.bar;
        __builtin_amdgcn_s_waitcnt(0);
        unsigned nloc = b.st[0], nx = b.st[1];
        if (nloc == 0u) { xcd_barrier_complete(bar, b.x, nloc, nx); b.st[0] = nloc; b.st[1] = nx; }
        const unsigned old = xb_add(&bar[XB_XSUB(b.x)], 1u);
        const unsigned gen = old / nloc;
        if (old + 1u == (gen + 1u) * nloc) {
            __builtin_amdgcn_fence(__ATOMIC_RELEASE, "agent");
            asm volatile("s_waitcnt vmcnt(0)" ::: "memory");
            const unsigned og = xb_add(&bar[XB_TOP], 1u);
            const unsigned tg = og / nx;
            if (og + 1u == (tg + 1u) * nx) xb_add(&bar[XB_TOPGEN], 1u);
            else XB_SPIN(xb_ld(&bar[XB_TOPGEN]) == tg, bar);
            __builtin_amdgcn_fence(__ATOMIC_ACQUIRE, "agent");
            xb_add(&bar[XB_XGEN(b.x)], 1u);
            asm volatile("s_waitcnt vmcnt(0)" ::: "memory");
        } else {
            XB_SPIN(xb_ld(&bar[XB_XGEN(b.x)]) == gen, bar);
            __builtin_amdgcn_fence(__ATOMIC_ACQUIRE, "agent");
            asm volatile("s_waitcnt vmcnt(0)" ::: "memory");
        }
    }
    __syncthreads();
}

namespace pg8 {
constexpr int BM = 256, BK = 64, HALF = 128, HTB = HALF * BK * 2, STAGE_BYTES = 8 * HTB, NXCD = 8, WGM = 8;
DI int lds_byte(int r, int c) { const int st = (r >> 4) * 2 + (c >> 5), rr = r & 15, cc = c & 31, ob = rr * 64 + cc * 2; return st * 1024 + (ob ^ (((ob >> 9) & 1) << 5)); }
DI void stage_rc(int b, int& R, int& C) { const int st = b / 1024, sb = b % 1024, swz = sb ^ (((sb >> 9) & 1) << 5); R = (st >> 1) * 16 + swz / 64; C = (st & 1) * 32 + (swz % 64) / 2; }
struct Unit { int pm, pn; };
struct Gemm { const u16* A; const u16* Bt; int M, N, K; };
struct StaticOrder {
    int nM, nN, nwg, G, c;
    DI void init(int M, int N, int G_, int c_) { nM = M / BM; nN = N / BM; nwg = nM * nN; G = G_; c = c_; }
    DI bool next(int i, Unit& u) const {
        const long L = (long)i * G + c; if (L >= nwg) return false;
        int wgid = (int)L; { const int q = nwg / NXCD, r = nwg % NXCD, xcd = wgid % NXCD, off = wgid / NXCD; wgid = (xcd < r ? xcd * (q + 1) : r * (q + 1) + (xcd - r) * q) + off; }
        const int nig = WGM * nN, gid = wgid / nig, fm = gid * WGM, gsz = (nM - fm) < WGM ? (nM - fm) : WGM;
        u.pm = fm + ((wgid % nig) % gsz); u.pn = (wgid % nig) / gsz;
        if (nN == 16 && ((u.pn >> 2) == 1 || (u.pn >> 2) == 2)) u.pn ^= 2;
        return true;
    }
};
struct SingleUnit {
    int pm, pn;
    DI bool next(int i, Unit& u) const { if (i) return false; u.pm = pm; u.pn = pn; return true; }
};

template <class Epi, class Sched>
DI void gemm_phase(LAS unsigned char* lds, const Gemm g, const Sched& S, const Epi& E) {
    const int tid = otid(), wid = __builtin_amdgcn_readfirstlane(tid >> 6), lane = tid & 63, wr = wid >> 2, wc = wid & 3, fr = lane & 15, fq = lane >> 4;
    const int K = g.K, nt = K / BK;
    unsigned voffA[2], voffB[2];
#pragma unroll
    for (int i = 0; i < 2; ++i) { int R, C; stage_rc(tid * 16 + i * 8192, R, C); const int rho = R & 31; const int Rb = Epi::PERM ? ((R & ~31) + 8 * ((rho & 15) >> 2) + 4 * (rho >> 4) + (rho & 3)) : R;
        voffA[i] = (unsigned)(R * K + C) * 2u; voffB[i] = (unsigned)(Rb * K + C) * 2u; }
    const size_t kstep = (size_t)(BK * 2);
    const size_t hstep = (size_t)HALF * K * 2;
    const size_t tstep = 2 * hstep;
    const unsigned ldsw = (unsigned)wid * 1024u;
    const int aoff = lds_byte(wr * 64 + fr, fq * 8), boff = lds_byte(wc * 32 + fr, fq * 8);
#define PG8_SA(b, h) (((b) * 2 + (h)) * HTB)
#define PG8_SB(b, h) ((4 + (b) * 2 + (h)) * HTB)
#define PG8_STAGE(bufoff, gbase, voff) do { _Pragma("unroll") for (int _i = 0; _i < 2; ++_i) \
        __builtin_amdgcn_global_load_lds((const unsigned*)((const char*)(gbase) + (voff)[_i]), (LAS unsigned*)(lds + (bufoff) + ldsw + _i * 8192), 16, 0, 0); } while (0)
#define PG8_LDA(dst, b, h) do { _Pragma("unroll") for (int m = 0; m < 4; ++m) _Pragma("unroll") for (int k = 0; k < 2; ++k) dst[m][k] = *(const LAS bf16x8*)(lds + PG8_SA(b, h) + aoff + m * 2048 + k * 1024); } while (0)
#define PG8_LDB(dst, b, h) do { _Pragma("unroll") for (int n = 0; n < 2; ++n) _Pragma("unroll") for (int k = 0; k < 2; ++k) dst[n][k] = *(const LAS bf16x8*)(lds + PG8_SB(b, h) + boff + n * 2048 + k * 1024); } while (0)
#define PG8_MMA(ai, bj, At, Bt) do { __builtin_amdgcn_s_setprio(1); _Pragma("unroll") for (int m = 0; m < 4; ++m) _Pragma("unroll") for (int n = 0; n < 2; ++n) _Pragma("unroll") for (int k = 0; k < 2; ++k) \
        acc[ai][bj][m][n] = __builtin_amdgcn_mfma_f32_16x16x32_bf16(Bt[n][k], At[m][k], acc[ai][bj][m][n], 0, 0, 0); __builtin_amdgcn_s_setprio(0); } while (0)
#define PG8_WAIT_V(n) asm volatile("s_waitcnt vmcnt(" #n ")" ::: "memory")
#define PG8_WAIT_L(n) asm volatile("s_waitcnt lgkmcnt(" #n ")" ::: "memory")
#define PG8_BAR __builtin_amdgcn_s_barrier()
#define PG8_SCHED __builtin_amdgcn_sched_barrier(0)
    Unit cur, nxt; int ui = 0;
    if (!S.next(0, cur)) return;
    f32x4 acc[2][2][4][2];
#pragma unroll
    for (int a = 0; a < 2; ++a)
#pragma unroll
        for (int b = 0; b < 2; ++b)
#pragma unroll
            for (int m = 0; m < 4; ++m)
#pragma unroll
                for (int n = 0; n < 2; ++n) acc[a][b][m][n] = (f32x4){0.f, 0.f, 0.f, 0.f};
    bf16x8 At[4][2], B0[2][2], B1[2][2];
    const char* cA = (const char*)g.A + (size_t)cur.pm * tstep; const char* cB = (const char*)g.Bt + (size_t)cur.pn * tstep;
    PG8_STAGE(PG8_SB(0, 0), cB, voffB); PG8_STAGE(PG8_SA(0, 0), cA, voffA); PG8_STAGE(PG8_SB(0, 1), cB + hstep, voffB); PG8_STAGE(PG8_SA(0, 1), cA + hstep, voffA);
    if (wr == 1) PG8_BAR;
    PG8_WAIT_V(4); PG8_BAR;
    PG8_STAGE(PG8_SB(1, 0), cB + kstep, voffB); PG8_STAGE(PG8_SA(1, 0), cA + kstep, voffA); PG8_STAGE(PG8_SB(1, 1), cB + hstep + kstep, voffB);
    PG8_WAIT_V(6); PG8_BAR;
    for (;;) {
        const bool has_next = S.next(ui + 1, nxt);
        const char* nA = has_next ? (const char*)g.A + (size_t)nxt.pm * tstep : cA; const char* nB = has_next ? (const char*)g.Bt + (size_t)nxt.pn * tstep : cB;
        for (int t = 0; t < nt; t += 2) {
            const bool last = (t == nt - 2);
            const char* a1 = cA + (size_t)(t + 1) * kstep;
            const char* a2 = last ? nA : cA + (size_t)(t + 2) * kstep; const char* b2 = last ? nB : cB + (size_t)(t + 2) * kstep;
            const char* a3 = a2 + kstep; const char* b3 = b2 + kstep;
            PG8_LDB(B0, 0, 0); PG8_SCHED; PG8_LDA(At, 0, 0); PG8_STAGE(PG8_SA(1, 1), a1 + hstep, voffA);
            PG8_WAIT_L(8); PG8_BAR; PG8_WAIT_L(0); PG8_MMA(0, 0, At, B0); PG8_BAR; PG8_SCHED;
            PG8_LDB(B1, 0, 1); PG8_STAGE(PG8_SB(0, 0), b2, voffB);
            PG8_BAR; PG8_WAIT_L(0); PG8_MMA(0, 1, At, B1); PG8_BAR;
            PG8_LDA(At, 0, 1); PG8_STAGE(PG8_SA(0, 0), a2, voffA);
            PG8_BAR; PG8_WAIT_L(0); PG8_MMA(1, 0, At, B0); PG8_BAR; PG8_SCHED;
            PG8_STAGE(PG8_SB(0, 1), b2 + hstep, voffB);
            PG8_WAIT_V(6); PG8_BAR; PG8_MMA(1, 1, At, B1); PG8_BAR;
            PG8_LDB(B0, 1, 0); PG8_SCHED; PG8_LDA(At, 1, 0); PG8_STAGE(PG8_SA(0, 1), a2 + hstep, voffA);
            PG8_WAIT_L(8); PG8_BAR; PG8_WAIT_L(0); PG8_MMA(0, 0, At, B0); PG8_BAR; PG8_SCHED;
            PG8_LDB(B1, 1, 1); PG8_STAGE(PG8_SB(1, 0), b3, voffB);
            PG8_BAR; PG8_WAIT_L(0); PG8_MMA(0, 1, At, B1); PG8_BAR;
            PG8_LDA(At, 1, 1); PG8_STAGE(PG8_SA(1, 0), a3, voffA);
            PG8_BAR; PG8_WAIT_L(0); PG8_MMA(1, 0, At, B0); PG8_BAR; PG8_SCHED;
            PG8_STAGE(PG8_SB(1, 1), b3 + hstep, voffB);
            PG8_WAIT_V(6); PG8_BAR; PG8_MMA(1, 1, At, B1); PG8_BAR;
        }
        if constexpr (!Epi::AFTER_DRAIN) { int fr2 = fr, fq2 = fq, wr2 = wr, wc2 = wc; asm volatile("" : "+v"(fr2), "+v"(fq2), "+s"(wr2), "+s"(wc2)); E(acc, cur, wr2, wc2, fr2, fq2); }
        if (!has_next) break;
#pragma unroll
        for (int a = 0; a < 2; ++a)
#pragma unroll
            for (int b = 0; b < 2; ++b)
#pragma unroll
                for (int m = 0; m < 4; ++m)
#pragma unroll
                    for (int n = 0; n < 2; ++n) acc[a][b][m][n] = (f32x4){0.f, 0.f, 0.f, 0.f};
        cur = nxt; cA = nA; cB = nB; ++ui;
    }
    PG8_WAIT_V(0);
    if (wr == 0) PG8_BAR;
    PG8_BAR;
    if constexpr (Epi::AFTER_DRAIN) { int fr2 = fr, fq2 = fq, wr2 = wr, wc2 = wc, tid2 = tid; asm volatile("" : "+v"(fr2), "+v"(fq2), "+s"(wr2), "+s"(wc2), "+v"(tid2)); E.fused(acc, cur, wr2, wc2, fr2, fq2, lds, tid2); }
#undef PG8_SA
#undef PG8_SB
#undef PG8_STAGE
#undef PG8_LDA
#undef PG8_LDB
#undef PG8_MMA
#undef PG8_WAIT_V
#undef PG8_WAIT_L
#undef PG8_BAR
#undef PG8_SCHED
}
}

template <int SEG> DI f32x4 proj_aux(const P& p, int cc) {
    f32x4 a = {0.f, 0.f, 0.f, 0.f};
    if constexpr (SEG == 5) {
        const f32x4 l0 = *(const f32x4*)(p.lb_logits + cc), l1 = *(const f32x4*)(p.lb_logits + 512 + cc);
#pragma unroll
        for (int j = 0; j < 4; ++j) a[j] = sigm(l0[j] - l1[j]);
    }
    if constexpr (SEG == 7) a = *(const f32x4*)(p.norm_g + cc);
    return a;
}
template <int SEG> DI void proj_store(const P& p, int row, int cc, f32x4 v, f32x4 aux) {
    unsigned char* ws = p.ws;
    if constexpr (SEG == 5) {
        f32x4 g;
#pragma unroll
        for (int j = 0; j < 4; ++j) { const float lb = aux[j]; g[j] = flog(lb + (1.f - lb) * sigm(v[j])); }
        typedef _Float16 h16x4 __attribute__((ext_vector_type(4)));
        h16x4 gh4; gh4[0] = (_Float16)g[0]; gh4[1] = (_Float16)g[1]; gh4[2] = (_Float16)g[2]; gh4[3] = (_Float16)g[3];
        *(h16x4*)((_Float16*)(ws + OFF_G) + (size_t)row * 512 + cc) = gh4;
    } else {
        if constexpr (SEG == 1 || SEG == 2) {
            const int hd = cc >> 6, d = cc & 63;
            float* o;
            if (row < NP) { const int b = row >> 11, t = row & 2047; o = p.out + (SEG == 1 ? O_KP : O_VP) + ((size_t)((b * 8 + hd) * 2048 + t)) * 64 + d; }
            else { const int rs = row - NP, b = rs >> 4, t = rs & 15; o = p.out + (SEG == 1 ? O_KS : O_VS) + ((size_t)((b * 8 + hd) * 16 + t)) * 64 + d; }
            __builtin_nontemporal_store(v, (f32x4*)o);
        }
        if constexpr (SEG == 0) { v = v * QSCALE; }
        if constexpr (SEG == 3 || SEG == 4) {
#pragma unroll
            for (int j = 0; j < 4; ++j) v[j] = silu(v[j]);
        }
        if constexpr (SEG == 7) {
#pragma unroll
            for (int j = 0; j < 4; ++j) v[j] = silu(v[j]) * aux[j];
        }
        constexpr size_t off = SEG == 0 ? OFF_QA : SEG == 1 ? OFF_KA : SEG == 2 ? OFF_VA : SEG == 3 ? OFF_GA : SEG == 4 ? OFF_QH : SEG == 6 ? OFF_IH : OFF_GH;
        u32x2 w; w[0] = pk_bf16(v[0], v[1]); w[1] = pk_bf16(v[2], v[3]);
        *(u32x2*)((u16*)(ws + off) + (size_t)row * 512 + cc) = w;
    }
}
template <int SEG> DI void proj_store8(const P& p, int row, int cc, f32x4 v0, f32x4 v1, f32x4 a0, f32x4 a1) {
    unsigned char* ws = p.ws;
    if constexpr (SEG == 5) {
        typedef _Float16 h16x8 __attribute__((ext_vector_type(8)));
        h16x8 g8;
#pragma unroll
        for (int j = 0; j < 4; ++j) { g8[j] = (_Float16)flog(a0[j] + (1.f - a0[j]) * sigm(v0[j])); g8[4 + j] = (_Float16)flog(a1[j] + (1.f - a1[j]) * sigm(v1[j])); }
        *(h16x8*)((_Float16*)(ws + OFF_G) + (size_t)row * 512 + cc) = g8;
    } else {
        if constexpr (SEG == 1 || SEG == 2) {
            const int hd = cc >> 6, d = cc & 63;
            float* o;
            if (row < NP) { const int b = row >> 11, t = row & 2047; o = p.out + (SEG == 1 ? O_KP : O_VP) + ((size_t)((b * 8 + hd) * 2048 + t)) * 64 + d; }
            else { const int rs = row - NP, b = rs >> 4, t = rs & 15; o = p.out + (SEG == 1 ? O_KS : O_VS) + ((size_t)((b * 8 + hd) * 16 + t)) * 64 + d; }
            __builtin_nontemporal_store(v0, (f32x4*)o); __builtin_nontemporal_store(v1, (f32x4*)(o + 4));
        }
        if constexpr (SEG == 0) { v0 = v0 * QSCALE; v1 = v1 * QSCALE; }
        if constexpr (SEG == 3 || SEG == 4) {
#pragma unroll
            for (int j = 0; j < 4; ++j) { v0[j] = silu(v0[j]); v1[j] = silu(v1[j]); }
        }
        if constexpr (SEG == 7) {
#pragma unroll
            for (int j = 0; j < 4; ++j) { v0[j] = silu(v0[j]) * a0[j]; v1[j] = silu(v1[j]) * a1[j]; }
        }
        constexpr size_t off = SEG == 0 ? OFF_QA : SEG == 1 ? OFF_KA : SEG == 2 ? OFF_VA : SEG == 3 ? OFF_GA : SEG == 4 ? OFF_QH : SEG == 6 ? OFF_IH : OFF_GH;
        u32x4 w; w[0] = pk_bf16(v0[0], v0[1]); w[1] = pk_bf16(v0[2], v0[3]); w[2] = pk_bf16(v1[0], v1[1]); w[3] = pk_bf16(v1[2], v1[3]);
        *(u32x4*)((u16*)(ws + off) + (size_t)row * 512 + cc) = w;
    }
}
struct EpiProj {
    static constexpr bool PERM = true, AFTER_DRAIN = false;
    P p;
    template <int SEG>
    DI void seg(const f32x4 (&acc)[2][2][4][2], const pg8::Unit& u, int wr, int wc, int fr, int fq) const {
        const int colt = (u.pn & 1) * 256 + wc * 32 + 8 * fq;
        f32x4 aux[2][2];
#pragma unroll
        for (int bj = 0; bj < 2; ++bj)
#pragma unroll
            for (int n = 0; n < 2; ++n) aux[bj][n] = proj_aux<SEG>(p, colt + bj * 128 + n * 4);
#pragma unroll
        for (int ai = 0; ai < 2; ++ai)
#pragma unroll
            for (int m = 0; m < 4; ++m) {
                const int row = u.pm * 256 + ai * 128 + wr * 64 + m * 16 + fr;
#pragma unroll
                for (int bj = 0; bj < 2; ++bj) proj_store8<SEG>(p, row, colt + bj * 128, acc[ai][bj][m][0], acc[ai][bj][m][1], aux[bj][0], aux[bj][1]);
            }
    }
    DI void operator()(const f32x4 (&acc)[2][2][4][2], const pg8::Unit& u, int wr, int wc, int fr, int fq) const {
        switch (u.pn >> 1) {
            case 0: seg<0>(acc, u, wr, wc, fr, fq); break;
            case 1: seg<1>(acc, u, wr, wc, fr, fq); break;
            case 2: seg<2>(acc, u, wr, wc, fr, fq); break;
            case 3: seg<3>(acc, u, wr, wc, fr, fq); break;
            case 4: seg<4>(acc, u, wr, wc, fr, fq); break;
            case 5: seg<5>(acc, u, wr, wc, fr, fq); break;
            case 6: seg<6>(acc, u, wr, wc, fr, fq); break;
            default: seg<7>(acc, u, wr, wc, fr, fq); break;
        }
    }
};
DI f32x4 slice16(const u16* arow  , const u16* brow  ) {
    f32x4 acc = {0.f, 0.f, 0.f, 0.f};
#pragma unroll 8
    for (int k0 = 0; k0 < 1024; k0 += 32) acc = __builtin_amdgcn_mfma_f32_16x16x32_bf16(*(const bf16x8*)(brow + k0), *(const bf16x8*)(arow + k0), acc, 0, 0, 0);
    return acc;
}
DI void sample_proj(const P& p) {
    const int tid_ = otid(); const int lane = tid_ & 63, wid = tid_ >> 6, fr = lane & 15, fq = lane >> 4;
    for (int cb = blockIdx.x; cb < 256; cb += gridDim.x) {
        const int row = NP + 16 * wid + fr;
        const f32x4 acc = slice16((const u16*)(p.ws + OFF_XB) + (size_t)row * 1024 + 8 * fq, (const u16*)(p.ws + OFF_WINT) + (size_t)(16 * cb + fr) * 1024 + 8 * fq);
        const int cc = ((16 * cb) & 511) + 4 * fq;
        switch (cb >> 5) {
            case 0: proj_store<0>(p, row, cc, acc, proj_aux<0>(p, cc)); break;
            case 1: proj_store<1>(p, row, cc, acc, proj_aux<1>(p, cc)); break;
            case 2: proj_store<2>(p, row, cc, acc, proj_aux<2>(p, cc)); break;
            case 3: proj_store<3>(p, row, cc, acc, proj_aux<3>(p, cc)); break;
            case 4: proj_store<4>(p, row, cc, acc, proj_aux<4>(p, cc)); break;
            case 5: proj_store<5>(p, row, cc, acc, proj_aux<5>(p, cc)); break;
            case 6: proj_store<6>(p, row, cc, acc, proj_aux<6>(p, cc)); break;
            default: proj_store<7>(p, row, cc, acc, proj_aux<7>(p, cc)); break;
        }
    }
}

struct EpiLN {
    static constexpr bool PERM = false, AFTER_DRAIN = true;
    P p;
    DI void fused(f32x4 (&acc)[2][2][4][2], const pg8::Unit& u, int wr, int wc, int fr, int fq, LAS unsigned char* lds, int tid) const {
        LAS float* red = (LAS float*)lds;
        LAS float* rowstat = (LAS float*)(lds + 8192);
        float* stats = (float*)(p.ws + OFF_STATS);
        unsigned* ctr = (unsigned*)(p.ws + OFF_CTR) + u.pm * 64;
        const int col0 = u.pn * 256 + wc * 32 + 4 * fq;
#pragma unroll
        for (int ai = 0; ai < 2; ++ai)
#pragma unroll
            for (int m = 0; m < 4; ++m) {
                const int rl = ai * 128 + wr * 64 + m * 16 + fr, row = u.pm * 256 + rl;
                const float* xr = row < NP ? p.x_prompt + (size_t)row * 1024 : p.x_sample + (size_t)((row < NTOK ? row : NP) - NP) * 1024;
                float a1 = 0.f, a2 = 0.f;
#pragma unroll
                for (int bj = 0; bj < 2; ++bj)
#pragma unroll
                    for (int n = 0; n < 2; ++n) {
                        const f32x4 xv = __builtin_nontemporal_load((const f32x4*)(xr + col0 + bj * 128 + n * 16));
                        const f32x4 v = xv * ALPHA + acc[ai][bj][m][n];
                        acc[ai][bj][m][n] = v;
                        a1 += (v[0] + v[1]) + (v[2] + v[3]);
                        a2 += (v[0] * v[0] + v[1] * v[1]) + (v[2] * v[2] + v[3] * v[3]);
                    }
                a1 += __shfl_xor(a1, 16); a2 += __shfl_xor(a2, 16);
                a1 += __shfl_xor(a1, 32); a2 += __shfl_xor(a2, 32);
                if (fq == 0) { red[(rl * 4 + wc) * 2] = a1; red[(rl * 4 + wc) * 2 + 1] = a2; }
                if (m == 3) asm volatile("" ::: "memory");
            }
        __syncthreads();
        if (tid < 256) {
            float s1 = 0.f, s2 = 0.f;
#pragma unroll
            for (int w = 0; w < 4; ++w) { s1 += red[(tid * 4 + w) * 2]; s2 += red[(tid * 4 + w) * 2 + 1]; }
            float* dst = stats + ((size_t)(u.pm * 4 + u.pn) * 256 + tid) * 2;
            __hip_atomic_store(dst, s1, __ATOMIC_RELAXED, __HIP_MEMORY_SCOPE_AGENT);
            __hip_atomic_store(dst + 1, s2, __ATOMIC_RELAXED, __HIP_MEMORY_SCOPE_AGENT);
        }
        asm volatile("s_waitcnt vmcnt(0)" ::: "memory");
        __syncthreads();
        if (tid == 0) {
            __hip_atomic_fetch_add(ctr, 1u, __ATOMIC_RELAXED, __HIP_MEMORY_SCOPE_AGENT);
            while (__hip_atomic_load(ctr, __ATOMIC_RELAXED, __HIP_MEMORY_SCOPE_AGENT) < 4u) __builtin_amdgcn_s_sleep(1);
            __builtin_amdgcn_fence(__ATOMIC_ACQUIRE, "agent");
        }
        __syncthreads();
        if (tid < 256) {
            float s1 = 0.f, s2 = 0.f;
#pragma unroll
            for (int o = 0; o < 4; ++o) {
                const float* src = stats + ((size_t)(u.pm * 4 + o) * 256 + tid) * 2;
                s1 += __hip_atomic_load(src, __ATOMIC_RELAXED, __HIP_MEMORY_SCOPE_AGENT);
                s2 += __hip_atomic_load(src + 1, __ATOMIC_RELAXED, __HIP_MEMORY_SCOPE_AGENT);
            }
            const float mean = s1 * (1.f / 1024.f);
            const float var = fmaxf(s2 * (1.f / 1024.f) - mean * mean, 0.f);
            rowstat[tid * 2] = mean; rowstat[tid * 2 + 1] = rsqrtf(var + 1e-5f);
        }
        __syncthreads();
        f32x4 gv[2][2], bv[2][2];
#pragma unroll
        for (int bj = 0; bj < 2; ++bj)
#pragma unroll
            for (int n = 0; n < 2; ++n) { gv[bj][n] = *(const f32x4*)(p.ln_g + col0 + bj * 128 + n * 16); bv[bj][n] = *(const f32x4*)(p.ln_b + col0 + bj * 128 + n * 16); }
#pragma unroll
        for (int ai = 0; ai < 2; ++ai)
#pragma unroll
            for (int m = 0; m < 4; ++m) {
                const int rl = ai * 128 + wr * 64 + m * 16 + fr, row = u.pm * 256 + rl;
                if (row >= NTOK) continue;
                const float mean = rowstat[rl * 2], rstd = rowstat[rl * 2 + 1];
                float* yr = row < NP ? p.out + O_YP + (size_t)row * 1024 : p.out + O_YS + (size_t)(row - NP) * 1024;
#pragma unroll
                for (int bj = 0; bj < 2; ++bj)
#pragma unroll
                    for (int n = 0; n < 2; ++n) __builtin_nontemporal_store((acc[ai][bj][m][n] - mean) * rstd * gv[bj][n] + bv[bj][n], (f32x4*)(yr + col0 + bj * 128 + n * 16));
                asm volatile("" ::: "memory");
            }
    }
};

DI void phase0(const P& p, unsigned char* shm) {
    const int tid = otid(), nb = gridDim.x, bid = blockIdx.x;
    u16* XB = (u16*)(p.ws + OFF_XB);
    const size_t n8p = (size_t)NP * 128, n8 = (size_t)NTOK * 128;
    const size_t stride = (size_t)nb * 512, ifirst = (size_t)bid * 512 + tid;
    float4 xa[5][4], xb[5][4];
    auto ldx = [&](int k) {
#pragma unroll
        for (int u = 0; u < 4; ++u) { const size_t i = ifirst + (size_t)(4 * k + u) * stride;
            if (i < n8) { const float4* src = (i < n8p) ? ((const float4*)p.x_prompt + 2 * i) : ((const float4*)p.x_sample + 2 * (i - n8p)); const f32x4 va = __builtin_nontemporal_load((const f32x4*)src), vb = __builtin_nontemporal_load((const f32x4*)src + 1); xa[k][u] = make_float4(va[0], va[1], va[2], va[3]); xb[k][u] = make_float4(vb[0], vb[1], vb[2], vb[3]); } }
    };
    auto stx = [&](int k) {
#pragma unroll
        for (int u = 0; u < 4; ++u) { const size_t i = ifirst + (size_t)(4 * k + u) * stride;
            if (i < n8) { uint4 o; o.x = pk_bf16(xa[k][u].x, xa[k][u].y); o.y = pk_bf16(xa[k][u].z, xa[k][u].w); o.z = pk_bf16(xb[k][u].x, xb[k][u].y); o.w = pk_bf16(xb[k][u].z, xb[k][u].w); ((uint4*)XB)[i] = o; } }
    };
    ldx(0); ldx(1);
    {
        u16* tile = (u16*)shm;
        float4 ta[5], tb[5];
        const int k = tid >> 3, n0 = (tid & 7) * 8;
#pragma unroll
        for (int i = 0; i < 5; ++i) {
            const int t = bid + i * nb;
            if (t < 1280) {
                const float* W; int N, kt, ntl;
                if (t < 1024) { W = p.w_in; N = 4096; kt = t >> 6; ntl = t & 63; } else { const int u = t - 1024; W = p.w_out; N = 1024; kt = u >> 4; ntl = u & 15; }
                const float4* s = (const float4*)(W + (size_t)(kt * 64 + k) * N + ntl * 64 + n0);
                const f32x4 va = __builtin_nontemporal_load((const f32x4*)s), vb = __builtin_nontemporal_load((const f32x4*)s + 1); ta[i] = make_float4(va[0], va[1], va[2], va[3]); tb[i] = make_float4(vb[0], vb[1], vb[2], vb[3]);
            }
        }
#pragma unroll
        for (int i = 0; i < 5; ++i) {
            const int t = bid + i * nb;
            if (t < 1280) {
                u16* WT; int kt, ntl;
                if (t < 1024) { WT = (u16*)(p.ws + OFF_WINT); kt = t >> 6; ntl = t & 63; } else { const int u = t - 1024; WT = (u16*)(p.ws + OFF_WOUTT); kt = u >> 4; ntl = u & 15; }
                const float4 a = ta[i], b = tb[i];
                tile[(n0 + 0) * 66 + k] = bf1(a.x); tile[(n0 + 1) * 66 + k] = bf1(a.y); tile[(n0 + 2) * 66 + k] = bf1(a.z); tile[(n0 + 3) * 66 + k] = bf1(a.w);
                tile[(n0 + 4) * 66 + k] = bf1(b.x); tile[(n0 + 5) * 66 + k] = bf1(b.y); tile[(n0 + 6) * 66 + k] = bf1(b.z); tile[(n0 + 7) * 66 + k] = bf1(b.w);
                lds_barrier();
                const int n = tid >> 3, k0 = (tid & 7) * 8;
                const unsigned* r = (const unsigned*)(tile + n * 66 + k0);
                uint4 o; o.x = r[0]; o.y = r[1]; o.z = r[2]; o.w = r[3];
                *(uint4*)(WT + (size_t)(ntl * 64 + n) * 1024 + kt * 64 + k0) = o;
                lds_barrier();
            }
        }
    }
    stx(0); ldx(2); stx(1); ldx(3); stx(2); ldx(4); stx(3); stx(4);
    for (int i = bid * 512 + tid; i < 16384; i += nb * 512) ((uint4*)(XB + (size_t)NTOK * 1024))[i] = make_uint4(0u, 0u, 0u, 0u);
}

template <bool SAMPLE>
DI void attn_wave(const P& p, int item, LAS unsigned char* vl, int lane) {
    const int col = lane & 31, h = lane >> 5;
    const int gi = (lane >> 4) & 1, i16 = lane & 15, tq = i16 >> 2, tp = i16 & 3;
    const u16* QA = (const u16*)(p.ws + OFF_QA);
    int b, hd, qt; size_t qrow;
    if (SAMPLE) { b = item >> 3; hd = item & 7; qt = 32; qrow = (size_t)NP + b * 16 + (col < 15 ? col : 15); }
    else { const int bh = item >> 6; qt = item & 63; b = bh >> 3; hd = bh & 7; qrow = (size_t)b * 2048 + 32 * qt + col; }
    const int qcol = SAMPLE ? (col < 15 ? col : 15) : col;
    bf16x8 qf[4];
#pragma unroll
    for (int s = 0; s < 4; ++s) qf[s] = *(const bf16x8*)(QA + qrow * 512 + hd * 64 + 16 * s + 8 * h);
    f32x16 o0, o1;
#pragma unroll
    for (int i = 0; i < 16; ++i) { o0[i] = 0.f; o1[i] = 0.f; }
    float R = 1.f;
    const u16* kbase = (const u16*)(p.ws + OFF_KA) + (size_t)b * 2048 * 512 + hd * 64;
    const u16* vbase = (const u16*)(p.ws + OFF_VA) + (size_t)b * 2048 * 512 + hd * 64;
    const float* ck = p.cache_k + (size_t)(b * 8 + hd) * 1024 * 64;
    const float* cv = p.cache_v + (size_t)(b * 8 + hd) * 1024 * 64;
    const float* nk = p.out + O_KS + (size_t)(b * 8 + hd) * 16 * 64;
    const float* nv = p.out + O_VS + (size_t)(b * 8 + hd) * 16 * 64;
    bf16x8 kn[4]; u32x4 vn[4];
    auto load_kv = [&](int j) {
        if (!SAMPLE) {
            const u16* kp = kbase + (size_t)(32 * j + col) * 512 + 8 * h;
#pragma unroll
            for (int s = 0; s < 4; ++s) kn[s] = *(const bf16x8*)(kp + 16 * s);
#pragma unroll
            for (int i = 0; i < 4; ++i) { const int c = lane + 64 * i; vn[i] = *(const u32x4*)(vbase + (size_t)(32 * j + (c >> 3)) * 512 + (c & 7) * 8); }
        } else {
            const bool fresh = (j == 32);
            const float* ksrc = fresh ? nk : ck; const float* vsrc = fresh ? nv : cv;
            const int r = fresh ? (col < 15 ? col : 15) : 32 * j + col;
            const float* kp = ksrc + (size_t)r * 64 + 8 * h;
#pragma unroll
            for (int s = 0; s < 4; ++s) kn[s] = pack8v(*(const float4*)(kp + 16 * s), *(const float4*)(kp + 16 * s + 4));
#pragma unroll
            for (int i = 0; i < 4; ++i) { const int c = lane + 64 * i; const int row = c >> 3; const int rr = fresh ? (row < 15 ? row : 15) : 32 * j + row;
                const float* vp = vsrc + (size_t)rr * 64 + (c & 7) * 8; const bf16x8 t8 = pack8v(*(const float4*)vp, *(const float4*)(vp + 4)); vn[i] = __builtin_bit_cast(u32x4, t8); }
        }
    };
    load_kv(qt);
    for (int j = qt; j >= 0; --j) {
        bf16x8 kf[4];
#pragma unroll
        for (int s = 0; s < 4; ++s) kf[s] = kn[s];
#pragma unroll
        for (int i = 0; i < 4; ++i) { const int c = lane + 64 * i; *(LAS u32x4*)(vl + (c >> 3) * 144 + (c & 7) * 16) = vn[i]; }
        if (j > 0) load_kv(j - 1);
        f32x16 st;
#pragma unroll
        for (int i = 0; i < 16; ++i) st[i] = 0.f;
#pragma unroll
        for (int s = 0; s < 4; ++s) st = MFMA32(kf[s], qf[s], st);
        const bool diag = (j == qt);
        float kp[16], bt[16], w[16];
#pragma unroll
        for (int i = 0; i < 16; i += 2) {
            f32x2 e2; e2[0] = ex2(fminf(st[i], 126.f)); e2[1] = ex2(fminf(st[i + 1], 126.f));
            const f32x2 d2 = e2 + 1.0f;
            f32x2 k2; k2[0] = __builtin_amdgcn_rcpf(d2[0]); k2[1] = __builtin_amdgcn_rcpf(d2[1]);
            const f32x2 b2 = e2 * k2;
            kp[i] = k2[0]; kp[i + 1] = k2[1]; bt[i] = b2[0]; bt[i + 1] = b2[1];
        }
        if (diag) {
#pragma unroll
            for (int i = 0; i < 16; ++i) if (!(crow(i, h) < qcol)) { kp[i] = 1.f; bt[i] = 0.f; }
        }
        float Go[4], Gp[4];
#pragma unroll
        for (int m = 0; m < 4; m += 2) {
            f32x2 a; a[0] = kp[4 * m]; a[1] = kp[4 * m + 4]; f32x2 b; b[0] = kp[4 * m + 1]; b[1] = kp[4 * m + 5];
            f32x2 c; c[0] = kp[4 * m + 2]; c[1] = kp[4 * m + 6]; f32x2 d; d[0] = kp[4 * m + 3]; d[1] = kp[4 * m + 7];
            const f32x2 g = (a * b) * (c * d);
            Go[m] = g[0]; Go[m + 1] = g[1];
        }
#pragma unroll
        for (int m = 0; m < 4; ++m) Gp[m] = xor32(Go[m], h);
        float bm[4]; float base = R;
#pragma unroll
        for (int m = 3; m >= 0; --m) { bm[m] = h == 0 ? base * Gp[m] : base; base *= Go[m] * Gp[m]; }
        R = base;
#pragma unroll
        for (int pr = 0; pr < 2; ++pr) {
            const int ma = 2 * pr + 1, mb = 2 * pr;
            f32x2 run; run[0] = bm[ma]; run[1] = bm[mb];
#pragma unroll
            for (int jj = 3; jj >= 0; --jj) {
                f32x2 bb; bb[0] = bt[4 * ma + jj]; bb[1] = bt[4 * mb + jj];
                const f32x2 ww = bb * run;
                w[4 * ma + jj] = ww[0]; w[4 * mb + jj] = ww[1];
                if (jj > 0) { f32x2 kk; kk[0] = kp[4 * ma + jj]; kk[1] = kp[4 * mb + jj]; run = run * kk; }
            }
        }
        const bf16x8 pw0 = pack8(w), pw1 = pack8(w + 8);
#pragma unroll
        for (int s2 = 0; s2 < 2; ++s2) {
            LAS unsigned char* lo = vl + (16 * s2 + 4 * h + tq) * 144 + (16 * gi + 4 * tp) * 2;
            const bf16x8 a0 = tr2(lo, lo + 8 * 144);
            const bf16x8 a1 = tr2(lo + 64, lo + 8 * 144 + 64);
            o0 = MFMA32(a0, s2 ? pw1 : pw0, o0);
            o1 = MFMA32(a1, s2 ? pw1 : pw0, o1);
        }
        if (__all(R < 1.17549435e-38f)) break;
    }
    {
#pragma unroll
        for (int dh = 0; dh < 2; ++dh)
#pragma unroll
            for (int g4 = 0; g4 < 4; ++g4) {
                f32x4 v4; v4[0] = dh ? o1[4 * g4] : o0[4 * g4]; v4[1] = dh ? o1[4 * g4 + 1] : o0[4 * g4 + 1]; v4[2] = dh ? o1[4 * g4 + 2] : o0[4 * g4 + 2]; v4[3] = dh ? o1[4 * g4 + 3] : o0[4 * g4 + 3];
                *(LAS f32x4*)(vl + col * 272 + (32 * dh + 8 * g4 + 4 * h) * 4) = v4;
            }
        asm volatile("s_waitcnt lgkmcnt(0)" ::: "memory");
#pragma unroll
        for (int i = 0; i < 4; ++i) {
            const int c = lane + 64 * i, qr = c >> 3, c8 = c & 7;
            if (!SAMPLE || qr < 16) {
                const size_t row = SAMPLE ? (size_t)NP + b * 16 + qr : (size_t)b * 2048 + 32 * qt + qr;
                const f32x4 a = *(const LAS f32x4*)(vl + qr * 272 + c8 * 32), bq = *(const LAS f32x4*)(vl + qr * 272 + c8 * 32 + 16);
                const u32x4 ga = *(const u32x4*)((const u16*)(p.ws + OFF_GA) + row * 512 + hd * 64 + c8 * 8);
                u32x4 wv;
                wv[0] = pk_bf16(a[0] * bflo(ga[0]), a[1] * bfhi(ga[0])); wv[1] = pk_bf16(a[2] * bflo(ga[1]), a[3] * bfhi(ga[1]));
                wv[2] = pk_bf16(bq[0] * bflo(ga[2]), bq[1] * bfhi(ga[2])); wv[3] = pk_bf16(bq[2] * bflo(ga[3]), bq[3] * bfhi(ga[3]));
                *(u32x4*)((u16*)(p.ws + OFF_XB) + row * 1024 + hd * 64 + c8 * 8) = wv;
            }
        }
        asm volatile("s_waitcnt lgkmcnt(0)" ::: "memory");
    }
}

struct ChunkRegs { u32x4 ih[2]; float g[16]; };
DI void chunk_load(const P& p, int ch, ChunkRegs& r) {
    const int tid = otid(), d = tid & 127, seg = tid >> 7;
    const int bh = ch >> 5, c = ch & 31, b = bh >> 2, hh = bh & 3;
    const size_t row0 = (size_t)b * 2048 + 64 * c;
    const u16* IH = (const u16*)(p.ws + OFF_IH) + row0 * 512 + hh * 128;
#pragma unroll
    for (int i = 0; i < 2; ++i) { const int cc = tid + 512 * i; r.ih[i] = *(const u32x4*)(IH + (size_t)(cc >> 4) * 512 + (cc & 15) * 8); }
    const _Float16* gp = (const _Float16*)(p.ws + OFF_G) + (row0 + 16 * seg) * 512 + hh * 128 + d;
#pragma unroll
    for (int i = 0; i < 16; ++i) r.g[i] = (float)gp[(size_t)i * 512];
}
DI void chunk_cumsum(const float (&gv)[16], float (&bc)[16], LAS float* segsum, int d, int seg, float& off, float& tot) {
    float run = 0.f;
#pragma unroll
    for (int i = 0; i < 16; ++i) { run += gv[i]; bc[i] = run; }
    segsum[seg * 128 + d] = run;
    lds_barrier();
    off = 0.f; tot = 0.f;
#pragma unroll
    for (int s4 = 0; s4 < 4; ++s4) { const float x = segsum[s4 * 128 + d]; tot += x; off += (s4 < seg) ? x : 0.f; }
}

DI void hgrn_local(const P& p, int ch, const ChunkRegs& r, LAS unsigned char* L) {
    const int tid = otid(), wid = tid >> 6, lane = tid & 63;
    LAS float* segsum = (LAS float*)L;
    LAS unsigned char* KT = L + 2048;
    LAS unsigned char* II = L + 2048 + 18432;
    LAS unsigned char* OUTS = L + 2048 + 18432 + 17408;
    const int d = tid & 127, seg = tid >> 7;
    float bc[16], off, tot;
#pragma unroll
    for (int i = 0; i < 2; ++i) { const int cc = tid + 512 * i; *(LAS u32x4*)(II + (cc >> 4) * 272 + (cc & 15) * 16) = r.ih[i]; }
    chunk_cumsum(r.g, bc, segsum, d, seg, off, tot);
    {
        float kx[16];
#pragma unroll
        for (int i = 0; i < 16; ++i) kx[i] = (1.f - __expf(r.g[i])) * __expf(tot - (off + bc[i]));
        *(LAS bf16x8*)(KT + d * 144 + seg * 32) = pack8(kx);
        *(LAS bf16x8*)(KT + d * 144 + seg * 32 + 16) = pack8(kx + 8);
        if (seg == 0) ((float*)(p.ws + OFF_BLAST))[(size_t)ch * 128 + d] = tot;
    }
    lds_barrier();
    {
        const int col = lane & 31, h = lane >> 5, gi = (lane >> 4) & 1, i16 = lane & 15, tq = i16 >> 2, tp = i16 & 3;
        const int vt = wid >> 1, dt0 = 2 * (wid & 1);
        f32x16 a0, a1;
#pragma unroll
        for (int i = 0; i < 16; ++i) { a0[i] = 0.f; a1[i] = 0.f; }
#pragma unroll
        for (int ks = 0; ks < 4; ++ks) {
            LAS unsigned char* lo = II + (16 * ks + 8 * h + tq) * 272 + (32 * vt + 16 * gi + 4 * tp) * 2;
            const bf16x8 A = tr2(lo, lo + 4 * 272);
            const bf16x8 B0 = *(const LAS bf16x8*)(KT + (32 * dt0 + col) * 144 + (16 * ks + 8 * h) * 2);
            const bf16x8 B1 = *(const LAS bf16x8*)(KT + (32 * (dt0 + 1) + col) * 144 + (16 * ks + 8 * h) * 2);
            a0 = MFMA32(A, B0, a0); a1 = MFMA32(A, B1, a1);
        }
#pragma unroll
        for (int i = 0; i < 16; ++i) {
            const int v = 32 * vt + crow(i, h);
            *(LAS u16*)(OUTS + v * 272 + (32 * dt0 + col) * 2) = bf1(a0[i]);
            *(LAS u16*)(OUTS + v * 272 + (32 * (dt0 + 1) + col) * 2) = bf1(a1[i]);
        }
    }
    lds_barrier();
    {
        u16* SL = (u16*)(p.ws + OFF_SLOC) + (size_t)ch * 16384;
#pragma unroll
        for (int i = 0; i < 4; ++i) { const int cc = tid + 512 * i; const int rr = cc >> 4, c16 = cc & 15; *(u32x4*)(SL + rr * 128 + c16 * 8) = *(const LAS u32x4*)(OUTS + rr * 272 + c16 * 16); }
    }
}

DI void hgrn_scan(const P& p, int first_block) {
    const int nthreads = ((int)gridDim.x - first_block) * 512, t0 = ((int)blockIdx.x - first_block) * 512 + otid();
    for (int gidx = t0; gidx < 65536; gidx += nthreads) {
        const int dg = gidx & 15, v = (gidx >> 4) & 127, bh = gidx >> 11;
        float S[8];
#pragma unroll
        for (int j = 0; j < 8; ++j) S[j] = 0.f;
        u16* base = (u16*)(p.ws + OFF_SLOC) + ((size_t)bh * 32 * 128 + v) * 128 + dg * 8;
        const float* bl = (const float*)(p.ws + OFF_BLAST) + (size_t)bh * 32 * 128 + dg * 8;
        for (int cb = 0; cb < 32; cb += 8) {
            u32x4 raw[8]; f32x4 d0[8], d1[8];
#pragma unroll
            for (int u = 0; u < 8; ++u) { raw[u] = *(const u32x4*)(base + (size_t)(cb + u) * 16384); d0[u] = *(const f32x4*)(bl + (cb + u) * 128); d1[u] = *(const f32x4*)(bl + (cb + u) * 128 + 4); }
#pragma unroll
            for (int u = 0; u < 8; ++u) {
                u32x4 o; o[0] = pk_bf16(S[0], S[1]); o[1] = pk_bf16(S[2], S[3]); o[2] = pk_bf16(S[4], S[5]); o[3] = pk_bf16(S[6], S[7]);
                *(u32x4*)(base + (size_t)(cb + u) * 16384) = o;
#pragma unroll
                for (int j = 0; j < 4; ++j) {
                    S[2 * j] = S[2 * j] * __expf(j < 2 ? d0[u][2 * j] : d1[u][2 * j - 4]) + bflo(raw[u][j]);
                    S[2 * j + 1] = S[2 * j + 1] * __expf(j < 2 ? d0[u][2 * j + 1] : d1[u][2 * j - 3]) + bfhi(raw[u][j]);
                }
            }
        }
        float* os = p.out + O_SP + ((size_t)bh * 128 + dg * 8) * 128 + v;
#pragma unroll
        for (int j = 0; j < 8; ++j) os[(size_t)j * 128] = S[j];
    }
}

struct OutRegs { ChunkRegs c; u16 q[16]; };
DI void out_load(const P& p, int ch, OutRegs& r) {
    chunk_load(p, ch, r.c);
    const int tid = otid(), d = tid & 127, seg = tid >> 7;
    const int bh = ch >> 5, c = ch & 31, b = bh >> 2, hh = bh & 3;
    const u16* QH = (const u16*)(p.ws + OFF_QH) + ((size_t)b * 2048 + 64 * c + 16 * seg) * 512 + hh * 128 + d;
#pragma unroll
    for (int i = 0; i < 16; ++i) r.q[i] = QH[(size_t)i * 512];
}
DI void hgrn_out(const P& p, int ch, const OutRegs& r, LAS unsigned char* L) {
    const int tid = otid(), wid = tid >> 6, lane = tid & 63;
    const int bh = ch >> 5, c = ch & 31, b = bh >> 2, hh = bh & 3;
    const size_t row0 = (size_t)b * 2048 + 64 * c;
    LAS float* segsum = (LAS float*)L;
    LAS unsigned char* QE = L + 2048;
    LAS unsigned char* KE = L + 2048 + 17408;
    LAS unsigned char* II = L + 2048 + 2 * 17408;
    LAS float* ssq = (LAS float*)(L + 2048 + 3 * 17408);
    const int d = tid & 127, seg = tid >> 7;
    const int col = lane & 31, h = lane >> 5, gi = (lane >> 4) & 1, i16 = lane & 15, tq = i16 >> 2, tp = i16 & 3;
    const int vi = wid & 3, ti = wid >> 2;
    bf16x8 sa[8]; u32x4 gh[2];
    {
        const u16* S0 = (const u16*)(p.ws + OFF_SLOC) + (size_t)ch * 16384 + (size_t)(32 * vi + col) * 128 + 8 * h;
#pragma unroll
        for (int kd = 0; kd < 8; ++kd) sa[kd] = *(const bf16x8*)(S0 + 16 * kd);
        const u16* GH = (const u16*)(p.ws + OFF_GH) + (row0 + (tid >> 3)) * 512 + hh * 128 + (tid & 7) * 16;
        gh[0] = *(const u32x4*)GH; gh[1] = *(const u32x4*)(GH + 8);
    }
    float bc[16], off, tot;
#pragma unroll
    for (int i = 0; i < 2; ++i) { const int cc = tid + 512 * i; *(LAS u32x4*)(II + (cc >> 4) * 272 + (cc & 15) * 16) = r.c.ih[i]; }
    chunk_cumsum(r.c.g, bc, segsum, d, seg, off, tot);
#pragma unroll
    for (int i = 0; i < 16; ++i) {
        const float bb = off + bc[i];
        const int s = 16 * seg + i;
        *(LAS u16*)(QE + s * 272 + d * 2) = bf1(bf2f(r.q[i]) * __expf(bb));
        *(LAS u16*)(KE + s * 272 + d * 2) = bf1((1.f - __expf(r.c.g[i])) * __expf(fminf(-bb, 80.f)));
    }
    lds_barrier();
    bf16x8 qf[8];
#pragma unroll
    for (int kd = 0; kd < 8; ++kd) qf[kd] = *(const LAS bf16x8*)(QE + (32 * ti + col) * 272 + (16 * kd + 8 * h) * 2);
    f32x16 o;
#pragma unroll
    for (int i = 0; i < 16; ++i) o[i] = 0.f;
#pragma unroll
    for (int kd = 0; kd < 8; ++kd) o = MFMA32(sa[kd], qf[kd], o);
#pragma unroll
    for (int si = 0; si < 2; ++si) {
        if (si <= ti) {
            f32x16 pt;
#pragma unroll
            for (int i = 0; i < 16; ++i) pt[i] = 0.f;
#pragma unroll
            for (int kd = 0; kd < 8; ++kd) { const bf16x8 ka = *(const LAS bf16x8*)(KE + (32 * si + col) * 272 + (16 * kd + 8 * h) * 2); pt = MFMA32(ka, qf[kd], pt); }
            float w[16];
#pragma unroll
            for (int i = 0; i < 16; ++i) w[i] = (si < ti || crow(i, h) <= col) ? pt[i] : 0.f;
            const bf16x8 pw0 = pack8(w), pw1 = pack8(w + 8);
#pragma unroll
            for (int s2 = 0; s2 < 2; ++s2) {
                LAS unsigned char* lo = II + (32 * si + 16 * s2 + 4 * h + tq) * 272 + (32 * vi + 16 * gi + 4 * tp) * 2;
                const bf16x8 A = tr2(lo, lo + 8 * 272);
                o = MFMA32(A, s2 ? pw1 : pw0, o);
            }
        }
    }
    {
        float ss = 0.f;
#pragma unroll
        for (int i = 0; i < 16; ++i) ss += o[i] * o[i];
        ss += __shfl_xor(ss, 32);
        if (h == 0) ssq[(32 * ti + col) * 4 + vi] = ss;
    }
    lds_barrier();
    {
        LAS unsigned char* OT = L + 2048;
        const int t = 32 * ti + col;
        const float tot2 = (ssq[t * 4] + ssq[t * 4 + 1]) + (ssq[t * 4 + 2] + ssq[t * 4 + 3]);
        const float rs = rsqrtf(tot2 * (1.f / 128.f) + 1e-6f);
#pragma unroll
        for (int g4 = 0; g4 < 4; ++g4) {
            f32x4 v4; v4[0] = o[4 * g4] * rs; v4[1] = o[4 * g4 + 1] * rs; v4[2] = o[4 * g4 + 2] * rs; v4[3] = o[4 * g4 + 3] * rs;
            *(LAS f32x4*)(OT + t * 528 + (32 * vi + 8 * g4 + 4 * h) * 4) = v4;
        }
        lds_barrier();
        const int tr_ = tid >> 3, c16 = tid & 7;
        f32x4 a[4];
#pragma unroll
        for (int q4 = 0; q4 < 4; ++q4) a[q4] = *(const LAS f32x4*)(OT + tr_ * 528 + c16 * 64 + q4 * 16);
        u32x4 w0, w1;
        w0[0] = pk_bf16(a[0][0] * bflo(gh[0][0]), a[0][1] * bfhi(gh[0][0])); w0[1] = pk_bf16(a[0][2] * bflo(gh[0][1]), a[0][3] * bfhi(gh[0][1]));
        w0[2] = pk_bf16(a[1][0] * bflo(gh[0][2]), a[1][1] * bfhi(gh[0][2])); w0[3] = pk_bf16(a[1][2] * bflo(gh[0][3]), a[1][3] * bfhi(gh[0][3]));
        w1[0] = pk_bf16(a[2][0] * bflo(gh[1][0]), a[2][1] * bfhi(gh[1][0])); w1[1] = pk_bf16(a[2][2] * bflo(gh[1][1]), a[2][3] * bfhi(gh[1][1]));
        w1[2] = pk_bf16(a[3][0] * bflo(gh[1][2]), a[3][1] * bfhi(gh[1][2])); w1[3] = pk_bf16(a[3][2] * bflo(gh[1][3]), a[3][3] * bfhi(gh[1][3]));
        u16* MX = (u16*)(p.ws + OFF_XB) + (row0 + tr_) * 1024 + 512 + hh * 128 + c16 * 16;
        *(u32x4*)MX = w0; *(u32x4*)(MX + 8) = w1;
    }
}

DI void sample_hgrn(const P& p, int bh, unsigned char* shm) {
    const int tid = otid(), b = bh >> 2, hh = bh & 3;
    float* F = (float*)shm; float* Q = F + 2048; float* I = Q + 2048; float* PART = I + 2048; float* O = PART + 8192;
    for (int e = tid; e < 2048; e += 512) {
        const int t = e >> 7, c = e & 127; const size_t off = (size_t)(NP + b * 16 + t) * 512 + hh * 128 + c;
        F[e] = __expf((float)((const _Float16*)(p.ws + OFF_G))[off]); Q[e] = bf2f(((const u16*)(p.ws + OFF_QH))[off]); I[e] = bf2f(((const u16*)(p.ws + OFF_IH))[off]);
    }
    const int v = tid & 127, dq = tid >> 7;
    float S[32];
#pragma unroll
    for (int dd = 0; dd < 32; ++dd) S[dd] = p.state_s[((size_t)bh * 128 + 32 * dq + dd) * 128 + v];
    lds_barrier();
    for (int t = 0; t < 16; ++t) {
        const float iv = I[t * 128 + v]; float po = 0.f;
        const float4* Fv = (const float4*)(F + t * 128 + 32 * dq); const float4* Qv = (const float4*)(Q + t * 128 + 32 * dq);
#pragma unroll
        for (int d4 = 0; d4 < 8; ++d4) {
            const float4 f = Fv[d4], q = Qv[d4];
            S[4 * d4] = f.x * S[4 * d4] + (1.f - f.x) * iv; po += S[4 * d4] * q.x;
            S[4 * d4 + 1] = f.y * S[4 * d4 + 1] + (1.f - f.y) * iv; po += S[4 * d4 + 1] * q.y;
            S[4 * d4 + 2] = f.z * S[4 * d4 + 2] + (1.f - f.z) * iv; po += S[4 * d4 + 2] * q.z;
            S[4 * d4 + 3] = f.w * S[4 * d4 + 3] + (1.f - f.w) * iv; po += S[4 * d4 + 3] * q.w;
        }
        PART[(dq * 16 + t) * 128 + v] = po;
    }
    lds_barrier();
    for (int e = tid; e < 2048; e += 512) O[e] = (PART[e] + PART[2048 + e]) + (PART[4096 + e] + PART[6144 + e]);
    lds_barrier();
#pragma unroll
    for (int dd = 0; dd < 32; ++dd) p.out[O_SS + ((size_t)bh * 128 + 32 * dq + dd) * 128 + v] = S[dd];
    {
        const int t = tid >> 5, l32 = tid & 31;
        const float4 o = *(const float4*)(O + t * 128 + l32 * 4);
        float ss = (o.x * o.x + o.y * o.y) + (o.z * o.z + o.w * o.w);
        ss += __shfl_xor(ss, 16); ss += __shfl_xor(ss, 8); ss += __shfl_xor(ss, 4); ss += __shfl_xor(ss, 2); ss += __shfl_xor(ss, 1);
        const float rs = rsqrtf(ss * (1.f / 128.f) + 1e-6f);
        const size_t row = (size_t)NP + b * 16 + t;
        const u32x2 gh = *(const u32x2*)((const u16*)(p.ws + OFF_GH) + row * 512 + hh * 128 + l32 * 4);
        u32x2 wv; wv[0] = pk_bf16(o.x * rs * bflo(gh[0]), o.y * rs * bfhi(gh[0])); wv[1] = pk_bf16(o.z * rs * bflo(gh[1]), o.w * rs * bfhi(gh[1]));
        *(u32x2*)((u16*)(p.ws + OFF_XB) + row * 1024 + 512 + hh * 128 + l32 * 4) = wv;
    }
}

DI void sample_out_proj(const P& p, int cb) {
    const int tid_ = otid(); const int lane = tid_ & 63, wid = tid_ >> 6, fr = lane & 15, fq = lane >> 4;
    const int r = 16 * wid + fr;
    const f32x4 acc = slice16((const u16*)(p.ws + OFF_XB) + (size_t)(NP + r) * 1024 + 8 * fq, (const u16*)(p.ws + OFF_WOUTT) + (size_t)(16 * cb + fr) * 1024 + 8 * fq);
    *(f32x4*)((float*)(p.ws + OFF_PRE) + (size_t)r * 1024 + 16 * cb + 4 * fq) = acc;
}
DI void sample_ln(const P& p, int r, int lane) {
    const float* xr = p.x_sample + (size_t)r * 1024; const float* pr = (const float*)(p.ws + OFF_PRE) + (size_t)r * 1024;
    f32x4 v[4]; float s = 0.f;
#pragma unroll
    for (int i = 0; i < 4; ++i) { v[i] = *(const f32x4*)(xr + 256 * i + 4 * lane) * ALPHA + *(const f32x4*)(pr + 256 * i + 4 * lane); s += (v[i][0] + v[i][1]) + (v[i][2] + v[i][3]); }
#pragma unroll
    for (int o = 32; o >= 1; o >>= 1) s += __shfl_xor(s, o);
    const float mean = s * (1.f / 1024.f); float q = 0.f;
#pragma unroll
    for (int i = 0; i < 4; ++i) { const f32x4 dd = v[i] - mean; q += (dd[0] * dd[0] + dd[1] * dd[1]) + (dd[2] * dd[2] + dd[3] * dd[3]); }
#pragma unroll
    for (int o = 32; o >= 1; o >>= 1) q += __shfl_xor(q, o);
    const float rstd = rsqrtf(q * (1.f / 1024.f) + 1e-5f);
    float* yr = p.out + O_YS + (size_t)r * 1024;
#pragma unroll
    for (int i = 0; i < 4; ++i) *(f32x4*)(yr + 256 * i + 4 * lane) = (v[i] - mean) * rstd * *(const f32x4*)(p.ln_g + 256 * i + 4 * lane) + *(const f32x4*)(p.ln_b + 256 * i + 4 * lane);
}

__global__ void __launch_bounds__(512, 2) mega(P p) {
    extern __shared__ __attribute__((aligned(16))) unsigned char shm[];
    LAS unsigned char* L = (LAS unsigned char*)shm;
    const int G = (int)gridDim.x, bid = (int)blockIdx.x;
    const bool multi = (p.ph_hi - p.ph_lo) > 1;
    volatile LAS unsigned* bst = (volatile LAS unsigned*)(L + 131072);
    if (threadIdx.x == 0) { bst[0] = 0u; bst[1] = 0u; }
    __syncthreads();
    const XcdBarrier xbar = xcd_barrier_post((unsigned*)(p.ws + OFF_BAR), bst);
#define GSYNC() xcd_barrier(xbar)
    unsigned long long tm0 = (TIMER_PH == 0) ? wall_clock64() : 0ull, tm1 = 0ull;
#define PH_ON(n) (p.ph_lo <= (n) && (n) < p.ph_hi && (PHMASK & (1 << (n))))
#define PH_SYNC(n) do { if (TIMER_PH == (n) && TIMER_PRE) tm1 = wall_clock64(); if (multi && p.ph_lo <= (n) && (n) + 1 < p.ph_hi) GSYNC(); if (TIMER_PH >= 0 && !(TIMER_PH == (n) && TIMER_PRE)) { const unsigned long long t_ = wall_clock64(); if (TIMER_PH == (n) + 1) tm0 = t_; if (TIMER_PH == (n)) tm1 = t_; } } while (0)
    REPS(0) { if (PH_ON(0)) phase0(p, shm); if (REP_PH == 0 && rep_ == 0) GSYNC(); }
    PH_SYNC(0);
    REPS(1) { if (REP_PH == 1 && rep_ == 1) GSYNC();
    if (PH_ON(1)) {
        pg8::StaticOrder S; S.init(NP, 4096, G, bid);
        pg8::Gemm g; g.A = (const u16*)(p.ws + OFF_XB); g.Bt = (const u16*)(p.ws + OFF_WINT); g.M = NP; g.N = 4096; g.K = 1024;
        EpiProj E; E.p = p;
        pg8::gemm_phase<EpiProj, pg8::StaticOrder>(L, g, S, E);
        sample_proj(p);
    } }
    PH_SYNC(1);
    REPS(2) { if (REP_PH == 2 && rep_ == 1) GSYNC();
    if (PH_ON(2)) {
        const int t2_ = otid(), wid2 = t2_ >> 6, lane2 = t2_ & 63;
        if (bid < 32) { sample_hgrn(p, bid, shm); lds_barrier(); }
        if (bid >= 32 && bid < 96 && wid2 == 0) {
            attn_wave<true>(p, bid - 32, L + wid2 * 9216, lane2);
        } else {
            const int r = bid < 32 ? bid * 8 + wid2 : (bid < 96 ? 256 + (bid - 32) * 7 + (wid2 - 1) : 704 + (bid - 96) * 8 + wid2);
            const int nit = (bid >= 96 && bid < 224 && wid2 == 1) ? 3 : 2;
            for (int q = 0; q < nit; ++q) attn_wave<false>(p, q == 0 ? r : (q == 1 ? r + 1984 : 3968 + (bid - 96)), L + wid2 * 9216, lane2);
        }
        ChunkRegs cur;
        if (bid < 1024) chunk_load(p, bid, cur);
        for (int ch = bid; ch < 1024; ch += G) {
            ChunkRegs nxt;
            const bool hn = ch + G < 1024;
            if (hn) chunk_load(p, ch + G, nxt);
            lds_barrier();
            hgrn_local(p, ch, cur, L);
            if (hn) cur = nxt;
        }
    } }
    PH_SYNC(2);
    if (PH_ON(3)) {
        if (bid < 64) sample_out_proj(p, bid);
        else hgrn_scan(p, 64);
    }
    PH_SYNC(3);
    REPS(4) { if (REP_PH == 4 && rep_ == 1) GSYNC();
    if (PH_ON(4)) {
        OutRegs cur;
        if (bid < 1024) out_load(p, bid, cur);
        for (int ch = bid; ch < 1024; ch += G) {
            OutRegs nxt;
            const bool hn = ch + G < 1024;
            if (hn) out_load(p, ch + G, nxt);
            lds_barrier();
            hgrn_out(p, ch, cur, L);
            if (hn) cur = nxt;
        }
    } }
    PH_SYNC(4);
    REPS(5) { if (REP_PH == 5 && rep_ == 1) GSYNC();
    if (PH_ON(5)) {
        if (bid < 16) { const int t_ = otid(); sample_ln(p, bid * 8 + (t_ >> 6), t_ & 63); }
        pg8::SingleUnit S; S.pm = bid & 63; S.pn = bid >> 6;
        pg8::Gemm g; g.A = (const u16*)(p.ws + OFF_XB); g.Bt = (const u16*)(p.ws + OFF_WOUTT); g.M = NP; g.N = 1024; g.K = 1024;
        EpiLN E; E.p = p;
        pg8::gemm_phase<EpiLN, pg8::SingleUnit>(L, g, S, E);
    } }
    if (TIMER_PH >= 0) {
        if (TIMER_PH == 5) { GSYNC(); tm1 = wall_clock64(); }
        if (bid == 0) {
            const float delta = (float)(tm1 - tm0) * 0.01f * (1.f / 300.f);
            for (int i = otid(); i < 65536; i += 512) p.out[O_KS + i] *= (1.f + delta);
        }
    }
}

extern "C" void kernel_launch(void* const* d_in, const int* in_sizes, int n_in, void* d_out, int out_size, void* d_ws, size_t ws_size, hipStream_t stream) {
    static int grid = 0;
    if (grid == 0) {
        int dev = 0, cus = 0, per_cu = 0;
        (void)hipGetDevice(&dev);
        (void)hipDeviceGetAttribute(&cus, hipDeviceAttributeMultiprocessorCount, dev);
        (void)hipFuncSetAttribute((const void*)mega, hipFuncAttributeMaxDynamicSharedMemorySize, LDS_BYTES);
        (void)hipOccupancyMaxActiveBlocksPerMultiprocessor(&per_cu, (const void*)mega, 512, LDS_BYTES);
        grid = cus * per_cu;
        if (grid > 256) grid = 256;
        if (grid != 256 || ws_size < WS_END) { fprintf(stderr, "kernel_launch: needs 256 co-resident workgroups (got %d x %d) and %zu B of workspace (got %zu)\n", cus, per_cu, (size_t)WS_END, ws_size); }
    }
    (void)hipMemsetAsync((unsigned char*)d_ws + OFF_CTR, 0, SZ_ZERO, stream);
    P p{};
    p.x_prompt = (const float*)d_in[0]; p.x_sample = (const float*)d_in[1]; p.cache_k = (const float*)d_in[2]; p.cache_v = (const float*)d_in[3];
    p.state_s = (const float*)d_in[4]; p.w_in = (const float*)d_in[5]; p.w_out = (const float*)d_in[6]; p.lb_logits = (const float*)d_in[7];
    p.norm_g = (const float*)d_in[8]; p.ln_g = (const float*)d_in[9]; p.ln_b = (const float*)d_in[10];
    p.out = (float*)d_out; p.ws = (unsigned char*)d_ws; p.ph_lo = 0; p.ph_hi = 6;
    void* args[] = {&p};
    hipError_t e = hipLaunchCooperativeKernel((const void*)mega, dim3(grid), dim3(512), args, LDS_BYTES, stream);
    if (e != hipSuccess) fprintf(stderr, "cooperative launch failed: %s (grid %d)\n", hipGetErrorString(e), grid);
}
```
